# Optimizing an MI355X kernel written in HIP

```python
import jax, jax.numpy as jnp
from jax import lax
import numpy as np

D_MODEL = 1024
BATCH = 2
SEQ = 8192
DEPTH = 4

CHUNK = 64
Q_BLOCK = 128
EPS = 1e-6
N_MOD = 6

MLA_HEADS = 8
MLA_NOPE = 64
MLA_ROPE = 32
MLA_V = 64
Q_LORA = 256
KV_LORA = 128
ROPE_BASE = 10000.0

SB_HEADS = 8
SB_HEAD_DIM = 64

MLA_WIDTH = MLA_HEADS * MLA_V
SB_WIDTH = SB_HEADS * SB_HEAD_DIM
MIX_WIDTH = MLA_WIDTH + SB_WIDTH
IN_COLS = Q_LORA + KV_LORA + MLA_ROPE + 3 * SB_WIDTH
SPLIT_POINTS = (Q_LORA, Q_LORA + KV_LORA, Q_LORA + KV_LORA + MLA_ROPE,
                Q_LORA + KV_LORA + MLA_ROPE + SB_WIDTH,
                Q_LORA + KV_LORA + MLA_ROPE + 2 * SB_WIDTH)

D_FF = 2560
N_EXPERTS = 8
TOP_K = 2
D_FF_EXPERT = 3584
N_DENSE = (DEPTH + 1) // 2
N_MOE = DEPTH // 2

kernel_name = 'hymba_mla_stickbreaking_moe_adaln_chunk_causal'


def rms_norm(x, g):
    xf = x.astype(jnp.float32)
    y = xf * lax.rsqrt(jnp.mean(xf * xf, axis=-1, keepdims=True) + EPS)
    return (y * g.astype(jnp.float32)).astype(x.dtype)


def apply_rotary(x, cos, sin):
    half = x.shape[-1] // 2
    x1, x2 = x[..., :half], x[..., half:]
    cos = cos.astype(x.dtype)
    sin = sin.astype(x.dtype)
    return jnp.concatenate([x1 * cos - x2 * sin, x2 * cos + x1 * sin], axis=-1)


def swiglu(x, w_gate, w_up, w_down):
    return (jax.nn.silu(x @ w_gate) * (x @ w_up)) @ w_down


def sweep_query_blocks(q, block_fn):
    b, h, s, dq = q.shape
    nb = s // Q_BLOCK
    qb = jnp.moveaxis(q.reshape(b, h, nb, Q_BLOCK, dq), 2, 0)
    out = lax.map(lambda args: block_fn(args[0], args[1]), (qb, jnp.arange(nb)))
    return jnp.moveaxis(out, 0, 2).reshape(b, h, s, out.shape[-1])


def mla_attention(q, k, v):
    scale = (MLA_NOPE + MLA_ROPE) ** -0.5
    key_chunk = jnp.arange(k.shape[2]) // CHUNK

    def block(qblk, i):
        q_chunk = (i * Q_BLOCK + jnp.arange(Q_BLOCK)) // CHUNK
        allowed = key_chunk[None, :] <= q_chunk[:, None]
        logits = jnp.einsum('bhqd,bhkd->bhqk', qblk, k,
                            preferred_element_type=jnp.float32) * scale
        logits = jnp.where(allowed, logits, -jnp.inf)
        p = jax.nn.softmax(logits, axis=-1)
        return jnp.einsum('bhqk,bhkd->bhqd', p.astype(v.dtype), v)

    return sweep_query_blocks(q, block)


def stick_breaking_attention(q, k, v):
    scale = SB_HEAD_DIM ** -0.5
    key_idx = jnp.arange(k.shape[2])

    def block(qblk, i):
        q_idx = i * Q_BLOCK + jnp.arange(Q_BLOCK)
        strict = key_idx[None, :] < q_idx[:, None]
        z = jnp.einsum('bhqd,bhkd->bhqk', qblk, k,
                       preferred_element_type=jnp.float32) * scale
        log_keep = jnp.where(strict, jax.nn.log_sigmoid(-z), 0.0)
        key_axis = log_keep.ndim - 1
        log_stick = lax.cumsum(log_keep, axis=key_axis, reverse=True) - log_keep
        a = jnp.where(strict, jnp.exp(jax.nn.log_sigmoid(z) + log_stick), 0.0)
        return jnp.einsum('bhqk,bhkd->bhqd', a.astype(v.dtype), v)

    return sweep_query_blocks(q, block)


def token_mixer(h, cos, sin, w_in, g_q_lat, w_uq, g_kv_lat, w_ukv, g_grp_mla, g_grp_sb, w_out):
    b, s, _ = h.shape
    proj = h @ w_in
    c_q, c_kv, k_rope, q_sb, k_sb, v_sb = jnp.split(proj, SPLIT_POINTS, axis=-1)

    q = (rms_norm(c_q, g_q_lat) @ w_uq).reshape(b, s, MLA_HEADS, MLA_NOPE + MLA_ROPE)
    q_nope = q[..., :MLA_NOPE]
    q_rope = apply_rotary(q[..., MLA_NOPE:], cos[:, :, None, :], sin[:, :, None, :])
    kv = (rms_norm(c_kv, g_kv_lat) @ w_ukv).reshape(b, s, MLA_HEADS, MLA_NOPE + MLA_V)
    k_nope, v_mla = kv[..., :MLA_NOPE], kv[..., MLA_NOPE:]
    k_rope = apply_rotary(k_rope, cos, sin)
    q_mla = jnp.concatenate([q_nope, q_rope], axis=-1)
    k_mla = jnp.concatenate(
        [k_nope, jnp.broadcast_to(k_rope[:, :, None, :], (b, s, MLA_HEADS, MLA_ROPE))], axis=-1)
    o_mla = mla_attention(q_mla.transpose(0, 2, 1, 3), k_mla.transpose(0, 2, 1, 3),
                          v_mla.transpose(0, 2, 1, 3))
    o_mla = o_mla.transpose(0, 2, 1, 3).reshape(b, s, MLA_WIDTH)

    def heads(t):
        return t.reshape(b, s, SB_HEADS, SB_HEAD_DIM).transpose(0, 2, 1, 3)
    o_sb = stick_breaking_attention(heads(q_sb), heads(k_sb), heads(v_sb))
    o_sb = o_sb.transpose(0, 2, 1, 3).reshape(b, s, SB_WIDTH)

    merged = jnp.concatenate([rms_norm(o_mla, g_grp_mla), rms_norm(o_sb, g_grp_sb)], axis=-1)
    return merged @ w_out


def moe_swiglu(h, w_router, b_router, w_gate, w_up, w_down):
    b, s, d = h.shape
    t = h.reshape(b * s, d)
    logits = (t @ w_router + b_router).astype(jnp.float32)
    top_vals, top_idx = lax.top_k(logits, TOP_K)
    top_w = jax.nn.softmax(top_vals, axis=-1)
    combine = jnp.sum(jax.nn.one_hot(top_idx, N_EXPERTS, dtype=jnp.float32) * top_w[..., None],
                      axis=1).astype(t.dtype)
    out = jnp.zeros_like(t)
    for e in range(N_EXPERTS):
        out = out + combine[:, e:e + 1] * swiglu(t, w_gate[e], w_up[e], w_down[e])
    return out.reshape(b, s, d)


def setup_inputs(seed: int = 0) -> dict:
    key = jax.random.key(seed)
    ks = jax.random.split(key, 24)
    f32 = jnp.float32

    def nrm(k, shape, scale):
        return jax.random.normal(k, shape, f32) * scale

    def gain(k, shape):
        return 1.0 + 0.1 * jax.random.normal(k, shape, f32)

    offset = jax.random.randint(ks[2], (BATCH, 1), 0, 64) * CHUNK
    positions = (offset + jnp.arange(SEQ, dtype=jnp.int32)[None, :]).astype(jnp.int32)
    return {
        'x': nrm(ks[0], (BATCH, SEQ, D_MODEL), 1.0),
        'c': nrm(ks[1], (BATCH, D_MODEL), 1.0),
        'positions': positions,
        'w_ada': nrm(ks[3], (DEPTH, D_MODEL, N_MOD * D_MODEL), 0.5 * D_MODEL ** -0.5),
        'b_ada': nrm(ks[4], (DEPTH, N_MOD * D_MODEL), 0.02),
        'g_mix': gain(ks[5], (DEPTH, D_MODEL)),
        'g_ffn': gain(ks[6], (DEPTH, D_MODEL)),
        'w_in': nrm(ks[7], (DEPTH, D_MODEL, IN_COLS), D_MODEL ** -0.5),
        'g_q_lat': gain(ks[8], (DEPTH, Q_LORA)),
        'w_uq': nrm(ks[9], (DEPTH, Q_LORA, MLA_HEADS * (MLA_NOPE + MLA_ROPE)), Q_LORA ** -0.5),
        'g_kv_lat': gain(ks[10], (DEPTH, KV_LORA)),
        'w_ukv': nrm(ks[11], (DEPTH, KV_LORA, MLA_HEADS * (MLA_NOPE + MLA_V)), KV_LORA ** -0.5),
        'g_grp_mla': gain(ks[12], (DEPTH, MLA_WIDTH)),
        'g_grp_sb': gain(ks[13], (DEPTH, SB_WIDTH)),
        'w_out': nrm(ks[14], (DEPTH, MIX_WIDTH, D_MODEL), MIX_WIDTH ** -0.5),
        'w_ff_gate': nrm(ks[15], (N_DENSE, D_MODEL, D_FF), D_MODEL ** -0.5),
        'w_ff_up': nrm(ks[16], (N_DENSE, D_MODEL, D_FF), D_MODEL ** -0.5),
        'w_ff_down': nrm(ks[17], (N_DENSE, D_FF, D_MODEL), D_FF ** -0.5),
        'w_router': nrm(ks[18], (N_MOE, D_MODEL, N_EXPERTS), D_MODEL ** -0.5),
        'b_router': nrm(ks[19], (N_MOE, N_EXPERTS), 0.01),
        'w_ex_gate': nrm(ks[20], (N_MOE, N_EXPERTS, D_MODEL, D_FF_EXPERT), D_MODEL ** -0.5),
        'w_ex_up': nrm(ks[21], (N_MOE, N_EXPERTS, D_MODEL, D_FF_EXPERT), D_MODEL ** -0.5),
        'w_ex_down': nrm(ks[22], (N_MOE, N_EXPERTS, D_FF_EXPERT, D_MODEL), D_FF_EXPERT ** -0.5),
        'g_final': gain(ks[23], (D_MODEL,)),
    }


def reference(x, c, positions, w_ada, b_ada, g_mix, g_ffn, w_in, g_q_lat, w_uq, g_kv_lat,
              w_ukv, g_grp_mla, g_grp_sb, w_out, w_ff_gate, w_ff_up, w_ff_down, w_router,
              b_router, w_ex_gate, w_ex_up, w_ex_down, g_final):
    half = MLA_ROPE // 2
    inv_freq = ROPE_BASE ** (-jnp.arange(half, dtype=jnp.float32) / half)
    ang = positions.astype(jnp.float32)[..., None] * inv_freq
    cos, sin = jnp.cos(ang), jnp.sin(ang)
    c_act = jax.nn.silu(c)

    for layer in range(DEPTH):
        mod = c_act @ w_ada[layer] + b_ada[layer]
        shift_m, scale_m, gate_m, shift_f, scale_f, gate_f = [
            m[:, None, :] for m in jnp.split(mod, N_MOD, axis=-1)]

        h = rms_norm(x, g_mix[layer]) * (1.0 + scale_m) + shift_m
        mixed = token_mixer(h, cos, sin, w_in[layer], g_q_lat[layer], w_uq[layer],
                            g_kv_lat[layer], w_ukv[layer], g_grp_mla[layer], g_grp_sb[layer],
                            w_out[layer])
        x = x + gate_m * mixed

        h = rms_norm(x, g_ffn[layer]) * (1.0 + scale_f) + shift_f
        if layer % 2 == 0:
            i = layer // 2
            y = swiglu(h, w_ff_gate[i], w_ff_up[i], w_ff_down[i])
        else:
            i = layer // 2
            y = moe_swiglu(h, w_router[i], b_router[i], w_ex_gate[i], w_ex_up[i], w_ex_down[i])
        x = x + gate_f * y

    return rms_norm(x, g_final)
```

```cpp
#include <hip/hip_runtime.h>
#include <cstdio>
#include <cstdint>

#define LAS __attribute__((address_space(3)))
#define GAS __attribute__((address_space(1)))
typedef unsigned short bf16_t;
typedef short bf16x8 __attribute__((ext_vector_type(8)));
typedef short s16x4 __attribute__((ext_vector_type(4)));
typedef float f32x2 __attribute__((ext_vector_type(2)));
typedef float f32x4 __attribute__((ext_vector_type(4)));
typedef float f32x16 __attribute__((ext_vector_type(16)));
typedef unsigned u32x2 __attribute__((ext_vector_type(2)));
typedef unsigned u32x4 __attribute__((ext_vector_type(4)));
typedef LAS unsigned char* ldsp;

constexpr int NB = 2, SEQ = 8192, MT = NB * SEQ, DM = 1024, NL = 4;
constexpr int INC = 1952, INP = 2048;
constexpr int QW = 768, KVW = 1024;
constexpr int DFF = 2560, DFE = 3584, NE = 8;
constexpr float EPS = 1e-6f;
constexpr float LOG2E = 1.4426950408889634f;
constexpr float C2Q = 0.10206207261596575f * LOG2E;
constexpr float C2S = 0.125f * LOG2E;
constexpr float SB_DONE = -150.0f;

constexpr size_t al256(size_t x) { return (x + 255) & ~(size_t)255; }
constexpr size_t WS_CTL = 0, CTL_BYTES = 65536;
constexpr size_t WS_MOD = WS_CTL + CTL_BYTES;
constexpr size_t WS_GS = WS_MOD + (size_t)NL * 2 * 6144 * 4;
constexpr size_t WS_COS = WS_GS + (size_t)NL * 4 * 2 * 1024 * 4;
constexpr size_t WS_SIN = WS_COS + (size_t)MT * 16 * 4;
constexpr size_t WS_BIN = WS_SIN + (size_t)MT * 16 * 4;
constexpr size_t WS_BGU = WS_BIN + (size_t)NL * 2 * INP * 4;
constexpr size_t WS_BEGU = WS_BGU + (size_t)2 * 2 * 2 * DFF * 4;
constexpr size_t WS_SSQX = WS_BEGU + (size_t)2 * NE * 2 * 2 * DFE * 4;
constexpr size_t WS_SSQL = WS_SSQX + (size_t)MT * 16 * 4;
constexpr size_t WS_SSQO = WS_SSQL + (size_t)MT * 8 * 4;
constexpr size_t WS_RTOK = WS_SSQO + (size_t)MT * 16 * 4;
constexpr size_t WS_ROWTOK = WS_RTOK + (size_t)MT * 4;
constexpr size_t WS_ROWW = WS_ROWTOK + (size_t)NE * MT * 4;
constexpr size_t WS_ROWR = WS_ROWW + (size_t)NE * MT * 4;
constexpr size_t WS_WIN = al256(WS_ROWR + (size_t)NE * MT * 4);
constexpr size_t WS_WUQ = WS_WIN + (size_t)NL * INP * 1024 * 2;
constexpr size_t WS_WUKV = WS_WUQ + (size_t)NL * QW * 256 * 2;
constexpr size_t WS_WOUT = WS_WUKV + (size_t)NL * KVW * 256 * 2;
constexpr size_t WS_WGU = WS_WOUT + (size_t)NL * 1024 * 1024 * 2;
constexpr size_t WS_WD = WS_WGU + (size_t)2 * 2 * DFF * 1024 * 2;
constexpr size_t WS_EGU = WS_WD + (size_t)2 * 1024 * DFF * 2;
constexpr size_t WS_ED = WS_EGU + (size_t)2 * NE * 2 * DFE * 1024 * 2;
constexpr size_t WS_X = WS_ED + (size_t)2 * NE * 1024 * DFE * 2;
constexpr size_t WS_AMIX = WS_X + (size_t)MT * 1024 * 4;
constexpr size_t WS_AFFN = WS_AMIX + (size_t)MT * 1024 * 2;
constexpr size_t WS_Y = WS_AFFN + (size_t)MT * 1024 * 2;
constexpr size_t WS_OVL = WS_Y + (size_t)2 * MT * 1024 * 2;
constexpr size_t WS_PROJ = WS_OVL;
constexpr size_t WS_QMLA = WS_PROJ + (size_t)MT * INP * 2;
constexpr size_t WS_KV = WS_QMLA + (size_t)MT * QW * 2;
constexpr size_t WS_OCAT = WS_KV + (size_t)MT * KVW * 2;
constexpr size_t WS_ACT = WS_OVL;
constexpr size_t WS_END = WS_OVL + (size_t)(2 * MT + 256) * DFE * 2;
static_assert(WS_OCAT + (size_t)MT * 1024 * 2 <= WS_END, "overlay");
static_assert(WS_END < (size_t)930 * 1024 * 1024, "workspace budget");
constexpr int CW_BAR = 1024;
constexpr int CW_QUEUE = 12288;
constexpr int CW_CNT = 8192;

constexpr int RING_BYTES = 131072;
constexpr int TAB_OFF = RING_BYTES;
constexpr int MISC_OFF = TAB_OFF + 10240;
constexpr int LDS_BYTES = 147456;

__device__ __forceinline__ unsigned cvt_pk_bf16(float lo, float hi) { unsigned r; asm volatile("v_cvt_pk_bf16_f32 %0, %1, %2" : "=v"(r) : "v"(lo), "v"(hi)); return r; }
__device__ __forceinline__ float clamp448(float x) { return __builtin_fminf(__builtin_fmaxf(x, -448.0f), 448.0f); }
__device__ __forceinline__ unsigned cvt4_fp8(float a, float b, float c, float d) {
    int p = __builtin_amdgcn_cvt_pk_fp8_f32(clamp448(a), clamp448(b), 0, false); p = __builtin_amdgcn_cvt_pk_fp8_f32(clamp448(c), clamp448(d), p, true); return (unsigned)p; }
constexpr float W8_SCALE = 64.0f, H8_SCALE = 16.0f;
__device__ __forceinline__ float bf_lo(unsigned u) { return __uint_as_float(u << 16); }
__device__ __forceinline__ float bf_hi(unsigned u) { return __uint_as_float(u & 0xffff0000u); }
__device__ __forceinline__ f32x4 gld4(const float* p) { return *(const GAS f32x4*)p; }
__device__ __forceinline__ f32x4 gld4_nt(const float* p) { return __builtin_nontemporal_load((const GAS f32x4*)p); }
__device__ __forceinline__ void gst4(float* p, f32x4 v) { *(GAS f32x4*)p = v; }
__device__ __forceinline__ void gst16(void* p, u32x4 v) { *(GAS u32x4*)p = v; }
__device__ __forceinline__ void gst8(void* p, u32x2 v) { *(GAS u32x2*)p = v; }
__device__ __forceinline__ float wave_sum(float v) {
#pragma unroll
    for (int o = 1; o < 64; o <<= 1) v += __shfl_xor(v, o);
    return v;
}
__device__ __forceinline__ int launder_s(int v) { asm volatile("" : "+s"(v)); return v; }
__device__ __forceinline__ int launder_v(int v) { asm volatile("" : "+v"(v)); return v; }
__device__ __forceinline__ float ex2(float x) { return __builtin_amdgcn_exp2f(x); }
__device__ __forceinline__ float lg2(float x) { return __builtin_amdgcn_logf(x); }
__device__ __forceinline__ float rcpf_(float x) { return __builtin_amdgcn_rcpf(x); }
__device__ __forceinline__ float rsq_(float x) { return 1.0f / sqrtf(x); }
__device__ __forceinline__ float silu_(float g) { return g * rcpf_(1.0f + ex2(-g * LOG2E)); }
__device__ __forceinline__ float sum16(const float* p) {
    const f32x4 a = gld4(p), b = gld4(p + 4), c = gld4(p + 8), d = gld4(p + 12);
    return ((a[0] + a[1]) + (a[2] + a[3])) + ((b[0] + b[1]) + (b[2] + b[3])) + ((c[0] + c[1]) + (c[2] + c[3])) + ((d[0] + d[1]) + (d[2] + d[3]));
}
__host__ __device__ __forceinline__ int ropedim(int p) { const int g = p >> 3, j = p & 7; return j < 4 ? 4 * g + j : 16 + 4 * g + (j - 4); }

#define XB_TMO      128
#define XB_XCNT(j)  (256  + 64 * (j))
#define XB_XSUB(j)  (1280 + 64 * (j))
#define XB_XGEN(j)  (2304 + 64 * (j))
#define XB_TOP      3328
#define XB_TOPGEN   3392
#define XCD_BAR_WORDS 3456
#define XB_SPIN_CAP (1u << 18)
__device__ __forceinline__ unsigned xb_ld(unsigned* p)              { return __hip_atomic_load(p, __ATOMIC_RELAXED, __HIP_MEMORY_SCOPE_AGENT); }
__device__ __forceinline__ unsigned xb_add(unsigned* p, unsigned v) { return __hip_atomic_fetch_add(p, v, __ATOMIC_RELAXED, __HIP_MEMORY_SCOPE_AGENT); }
__device__ __forceinline__ unsigned xb_xcc_id() { return (unsigned)__builtin_amdgcn_s_getreg((3 << 11) | 20) & 0xFu; }
#define XB_SPIN(cond, bar) do { unsigned _sp = 0; while (cond) { __builtin_amdgcn_s_sleep(1); \
    if ((++_sp & 255u) == 0u) { if (xb_ld(&(bar)[XB_TMO])) break; if (_sp > XB_SPIN_CAP) { atomicAdd(&(bar)[XB_TMO], 1u); break; } } } } while (0)
struct XcdBarrier { unsigned* bar; unsigned x; volatile LAS unsigned* st; };
__device__ __forceinline__ XcdBarrier xcd_barrier_post(unsigned* bar, volatile LAS unsigned* st) {
    XcdBarrier b; b.bar = bar; b.x = xb_xcc_id(); b.st = st;
    if (threadIdx.x == 0) (void)xb_add(&bar[XB_XCNT(b.x)], 1u);
    return b;
}
__device__ __forceinline__ void xcd_barrier_complete(unsigned* bar, unsigned x, unsigned& nloc, unsigned& nx) {
    const unsigned G = gridDim.x * gridDim.y * gridDim.z;
    unsigned sum, cnt, mine, sp = 0u;
    for (;;) {
        sum = 0u; cnt = 0u; mine = 0u;
#pragma unroll
        for (unsigned j = 0; j < 16; ++j) { const unsigned c = xb_ld(&bar[XB_XCNT(j)]); sum += c; cnt += (c > 0u) ? 1u : 0u; mine = (j == x) ? c : mine; }
        if (sum == G) break;
        __builtin_amdgcn_s_sleep(1);
        if ((++sp & 255u) == 0u) { if (xb_ld(&bar[XB_TMO])) break; if (sp > XB_SPIN_CAP) { atomicAdd(&bar[XB_TMO], 1u); break; } }
    }
    nloc = mine > 0u ? mine : 1u; nx = cnt > 0u ? cnt : 1u;
}
__device__ __forceinline__ void xcd_barrier(const XcdBarrier& b) {
    asm volatile("s_waitcnt vmcnt(0)" ::: "memory");
    __syncthreads();
    if (threadIdx.x == 0) {
        unsigned* bar = b.bar;
        __builtin_amdgcn_s_waitcnt(0);
        unsigned nloc = b.st[0], nx = b.st[1];
        if (nloc == 0u) { xcd_barrier_complete(bar, b.x, nloc, nx); b.st[0] = nloc; b.st[1] = nx; }
        const unsigned old = xb_add(&bar[XB_XSUB(b.x)], 1u);
        const unsigned gen = old / nloc;
        if (old + 1u == (gen + 1u) * nloc) {
            __builtin_amdgcn_fence(__ATOMIC_RELEASE, "agent");
            asm volatile("s_waitcnt vmcnt(0)" ::: "memory");
            const unsigned og = xb_add(&bar[XB_TOP], 1u);
            const unsigned tg = og / nx;
            if (og + 1u == (tg + 1u) * nx) xb_add(&bar[XB_TOPGEN], 1u);
            else XB_SPIN(xb_ld(&bar[XB_TOPGEN]) == tg, bar);
            __builtin_amdgcn_fence(__ATOMIC_ACQUIRE, "agent");
            xb_add(&bar[XB_XGEN(b.x)], 1u);
            asm volatile("s_waitcnt vmcnt(0)" ::: "memory");
        } else {
            XB_SPIN(xb_ld(&bar[XB_XGEN(b.x)]) == gen, bar);
            __builtin_amdgcn_fence(__ATOMIC_ACQUIRE, "agent");
            asm volatile("s_waitcnt vmcnt(0)" ::: "memory");
        }
    }
    __syncthreads();
}

namespace pg8 {
constexpr int BM = 256, BK = 64, HALF = 128, HTB = HALF * BK * 2, STAGE_BYTES = 8 * HTB, NXCD = 8, WGM = 8;
__host__ __device__ __forceinline__ int lds_byte(int r, int c) { const int st = (r >> 4) * 2 + (c >> 5), rr = r & 15, cc = c & 31, ob = rr * 64 + cc * 2; return st * 1024 + (ob ^ (((ob >> 9) & 1) << 5)); }
__host__ __device__ __forceinline__ void stage_rc(int b, int& R, int& C) { const int st = b / 1024, sb = b % 1024, swz = sb ^ (((sb >> 9) & 1) << 5); R = (st >> 1) * 16 + swz / 64; C = (st & 1) * 32 + (swz % 64) / 2; }
__host__ __device__ __forceinline__ int perm32(int rho) { const int n = rho >> 4, i = rho & 15; return 8 * (i >> 2) + 4 * n + (i & 3); }
struct Unit { int pm, pn; };
struct Order {
    int nM, nN, nwg, G, c;
    __device__ __forceinline__ void init(int nM_, int nN_, int G_, int c_) { nM = nM_; nN = nN_; nwg = nM * nN; G = G_; c = c_; }
    __device__ __forceinline__ bool next(int i, Unit& u) const {
        const long L = (long)i * G + c; if (L >= nwg) return false;
        int wgid = (int)L; { const int q = nwg / NXCD, r = nwg % NXCD, xcd = wgid % NXCD, off = wgid / NXCD; wgid = (xcd < r ? xcd * (q + 1) : r * (q + 1) + (xcd - r) * q) + off; }
        const int nig = WGM * nN, gid = wgid / nig, fm = gid * WGM, gsz = (nM - fm) < WGM ? (nM - fm) : WGM;
        u.pm = fm + ((wgid % nig) % gsz); u.pn = (wgid % nig) / gsz; return true;
    }
};
typedef f32x4 Acc[2][2][4][2];
typedef int v4i_t __attribute__((ext_vector_type(4)));
struct PBase {
    const char* A; const char* Bt; int K, lda; Order ord; int dry = 0;
    static constexpr bool GATHER = false, MIDK = false, FP8 = false; static constexpr int MIDT = 0;
    __device__ __forceinline__ bool next(int i, Unit& u) const { return ord.next(i, u); }
    __device__ __forceinline__ const char* a_tile(const Unit& u) const { return A + (size_t)u.pm * 256 * lda * 2; }
    __device__ __forceinline__ const char* b_tile(const Unit& u) const { return Bt + (size_t)u.pn * 256 * K * 2; }
    __device__ __forceinline__ void a_offs(const Unit&, unsigned (&)[2][2], const int (&)[2], const int (&)[2]) const {}
    __device__ __forceinline__ void midscale(Acc&, int, ldsp, int, int) const {}
};

template <class P, bool ALIGN_EPI>
__device__ __forceinline__ void gemm_phase(ldsp lds, ldsp tab, const P& S) {
    int tid_ = threadIdx.x; asm volatile("" : "+v"(tid_));
    const int tid = tid_, wid = __builtin_amdgcn_readfirstlane(tid >> 6), lane = tid & 63, wr = wid >> 2, wc = wid & 3, fr = lane & 15, fq = lane >> 4;
    const int K = S.K, nt = K / BK, lda = S.lda;
    unsigned voffA[2], voffB[2]; int sR[2], sC[2];
#pragma unroll
    for (int i = 0; i < 2; ++i) { int R, C; stage_rc(tid * 16 + i * 8192, R, C); sR[i] = R; sC[i] = C; const int Rb = P::PERM ? ((R & ~31) + perm32(R & 31)) : R;
        voffA[i] = (unsigned)(R * lda + C) * 2u; voffB[i] = (unsigned)(Rb * K + C) * 2u; }
    const size_t kstep = (size_t)(BK * 2);
    const size_t hstepA = (size_t)HALF * lda * 2, hstepB = (size_t)HALF * K * 2;
    const unsigned ldsw = (unsigned)wid * 1024u;
    const int aoff = lds_byte(wr * 64 + fr, fq * 8), boff = lds_byte(wc * 32 + fr, fq * 8);
#define PG8_SA(b, h) (((b) * 2 + (h)) * HTB)
#define PG8_SB(b, h) ((4 + (b) * 2 + (h)) * HTB)
#define PG8_GL(src, bufoff, i) __builtin_amdgcn_global_load_lds((const unsigned*)(src), (LAS unsigned*)(lds + (bufoff) + ldsw + (i) * 8192), 16, 0, 0)
#define PG8_STAGEB(bufoff, gbase) do { _Pragma("unroll") for (int _i = 0; _i < 2; ++_i) PG8_GL((const char*)(gbase) + voffB[_i], bufoff, _i); } while (0)
#define PG8_STAGEA(bufoff, ubase, offs, h, kb) do { _Pragma("unroll") for (int _i = 0; _i < 2; ++_i) { \
        if constexpr (P::GATHER) PG8_GL(S.A + (size_t)(kb) + (offs)[h][_i], bufoff, _i); \
        else PG8_GL((const char*)(ubase) + (size_t)(h) * hstepA + (size_t)(kb) + voffA[_i], bufoff, _i); } } while (0)
#define PG8_LDA(dst, b, h) do { _Pragma("unroll") for (int m = 0; m < 4; ++m) _Pragma("unroll") for (int k = 0; k < 2; ++k) dst[m][k] = *(const LAS bf16x8*)(lds + PG8_SA(b, h) + aoff + m * 2048 + k * 1024); } while (0)
#define PG8_LDB(dst, b, h) do { _Pragma("unroll") for (int n = 0; n < 2; ++n) _Pragma("unroll") for (int k = 0; k < 2; ++k) dst[n][k] = *(const LAS bf16x8*)(lds + PG8_SB(b, h) + boff + n * 2048 + k * 1024); } while (0)
#define PG8_CAT8(x) __builtin_shufflevector(__builtin_bit_cast(v4i_t, (x)[0]), __builtin_bit_cast(v4i_t, (x)[1]), 0, 1, 2, 3, 4, 5, 6, 7)
#define PG8_MMA(ai, bj, At, Bt) do { __builtin_amdgcn_s_setprio(1); \
        if constexpr (P::FP8) { _Pragma("unroll") for (int m = 0; m < 4; ++m) _Pragma("unroll") for (int n = 0; n < 2; ++n) \
            asm volatile("v_mfma_scale_f32_16x16x128_f8f6f4 %0, %1, %2, %0, %3, %3 op_sel_hi:[0,0,0]" : "+v"(acc[ai][bj][m][n]) : "v"(PG8_CAT8(Bt[n])), "v"(PG8_CAT8(At[m])), "v"(sc8)); } \
        else { _Pragma("unroll") for (int m = 0; m < 4; ++m) _Pragma("unroll") for (int n = 0; n < 2; ++n) _Pragma("unroll") for (int k = 0; k < 2; ++k) \
            acc[ai][bj][m][n] = __builtin_amdgcn_mfma_f32_16x16x32_bf16(Bt[n][k], At[m][k], acc[ai][bj][m][n], 0, 0, 0); } \
        __builtin_amdgcn_s_setprio(0); } while (0)
#define PG8_WAIT_V(n) asm volatile("s_waitcnt vmcnt(" #n ")" ::: "memory")
#define PG8_WAIT_L(n) asm volatile("s_waitcnt lgkmcnt(" #n ")" ::: "memory")
#define PG8_BAR __builtin_amdgcn_s_barrier()
#define PG8_SCHED __builtin_amdgcn_sched_barrier(0)
    Unit cur, nxt; int ui = 0;
    if (!S.next(0, cur)) return;
    Acc acc;
#pragma unroll
    for (int a = 0; a < 2; ++a)
#pragma unroll
        for (int b = 0; b < 2; ++b)
#pragma unroll
            for (int m = 0; m < 4; ++m)
#pragma unroll
                for (int n = 0; n < 2; ++n) acc[a][b][m][n] = (f32x4){0.f, 0.f, 0.f, 0.f};
    bf16x8 At[4][2], B0[2][2], B1[2][2];
    const int sc8 = 0x7F7F7F7F; (void)sc8;
    const char* cA = S.a_tile(cur); const char* cB = S.b_tile(cur);
    unsigned goc[2][2] = {{0u, 0u}, {0u, 0u}}, gon[2][2] = {{0u, 0u}, {0u, 0u}};
    if constexpr (P::GATHER) S.a_offs(cur, goc, sR, sC);
    S.prepare(cur, 0, tab);
    PG8_STAGEB(PG8_SB(0, 0), cB); PG8_STAGEB(PG8_SB(0, 1), cB + hstepB); PG8_STAGEA(PG8_SA(0, 0), cA, goc, 0, 0); PG8_STAGEA(PG8_SA(0, 1), cA, goc, 1, 0);
    if (wr == 1) PG8_BAR;
    PG8_WAIT_V(2); PG8_BAR;
    PG8_STAGEB(PG8_SB(1, 0), cB + kstep); PG8_STAGEA(PG8_SA(1, 0), cA, goc, 0, kstep); PG8_STAGEB(PG8_SB(1, 1), cB + hstepB + kstep);
    PG8_WAIT_V(6); PG8_BAR;
    for (;;) {
        const bool has_next = S.next(ui + 1, nxt);
        const char* nA = has_next ? S.a_tile(nxt) : cA; const char* nB = has_next ? S.b_tile(nxt) : cB;
        if constexpr (P::GATHER) { if (has_next) S.a_offs(nxt, gon, sR, sC); else { gon[0][0] = goc[0][0]; gon[0][1] = goc[0][1]; gon[1][0] = goc[1][0]; gon[1][1] = goc[1][1]; } }
        for (int t = 0; t < nt; t += 2) {
            const bool last = (t == nt - 2);
            asm volatile("" : "+v"(voffA[0]), "+v"(voffA[1]), "+v"(voffB[0]), "+v"(voffB[1]));
            const size_t kb1 = (size_t)(t + 1) * kstep, kb2 = last ? (size_t)0 : (size_t)(t + 2) * kstep, kb3 = kb2 + kstep;
            const char* uA2 = last ? nA : cA; const char* b2 = (last ? nB : cB) + kb2; const char* b3 = b2 + kstep;
            unsigned o2[2][2];
            if constexpr (P::GATHER) { o2[0][0] = last ? gon[0][0] : goc[0][0]; o2[0][1] = last ? gon[0][1] : goc[0][1]; o2[1][0] = last ? gon[1][0] : goc[1][0]; o2[1][1] = last ? gon[1][1] : goc[1][1]; }
            PG8_LDB(B0, 0, 0); PG8_LDB(B1, 0, 1); PG8_SCHED; PG8_LDA(At, 0, 0); PG8_STAGEA(PG8_SA(1, 1), cA, goc, 1, kb1);
            PG8_WAIT_V(8); PG8_WAIT_L(0); PG8_BAR; PG8_MMA(0, 0, At, B0); PG8_MMA(0, 1, At, B1); PG8_BAR; PG8_SCHED;
            PG8_LDA(At, 0, 1); PG8_STAGEB(PG8_SB(0, 0), b2); PG8_STAGEB(PG8_SB(0, 1), b2 + hstepB); PG8_STAGEA(PG8_SA(0, 0), uA2, o2, 0, kb2);
            PG8_WAIT_V(8); PG8_WAIT_L(0); PG8_BAR; PG8_MMA(1, 0, At, B0); PG8_MMA(1, 1, At, B1); PG8_BAR; PG8_SCHED;
            PG8_LDB(B0, 1, 0); PG8_LDB(B1, 1, 1); PG8_SCHED; PG8_LDA(At, 1, 0); PG8_STAGEA(PG8_SA(0, 1), uA2, o2, 1, kb2);
            PG8_WAIT_V(8); PG8_WAIT_L(0); PG8_BAR; PG8_MMA(0, 0, At, B0); PG8_MMA(0, 1, At, B1); PG8_BAR; PG8_SCHED;
            PG8_LDA(At, 1, 1); PG8_STAGEB(PG8_SB(1, 0), b3); PG8_STAGEB(PG8_SB(1, 1), b3 + hstepB); PG8_STAGEA(PG8_SA(1, 0), uA2, o2, 0, kb3);
            PG8_WAIT_V(8); PG8_WAIT_L(0); PG8_BAR; PG8_MMA(1, 0, At, B0); PG8_MMA(1, 1, At, B1); PG8_BAR; PG8_SCHED;
            if constexpr (P::MIDK) { if (t == P::MIDT - 2) S.midscale(acc, ui & 1, tab, wr, fr); }
        }
        if constexpr (P::FP8) asm volatile("s_nop 15\n\ts_nop 15\n\ts_nop 15\n\ts_nop 15" ::: "memory");
        if constexpr (ALIGN_EPI) { if (wr == 0) PG8_BAR; }
        if (!S.dry) S.epi(acc, cur, ui & 1, tab, wr, wc, launder_v(fr), launder_v(fq));
        if (has_next && S.dry < 2) S.prepare(nxt, (ui + 1) & 1, tab);
        if (!has_next) break;
#pragma unroll
        for (int a = 0; a < 2; ++a)
#pragma unroll
            for (int b = 0; b < 2; ++b)
#pragma unroll
                for (int m = 0; m < 4; ++m)
#pragma unroll
                    for (int n = 0; n < 2; ++n) acc[a][b][m][n] = (f32x4){0.f, 0.f, 0.f, 0.f};
        cur = nxt; cA = nA; cB = nB; ++ui;
        if constexpr (P::GATHER) { goc[0][0] = gon[0][0]; goc[0][1] = gon[0][1]; goc[1][0] = gon[1][0]; goc[1][1] = gon[1][1]; }
        if constexpr (ALIGN_EPI) { if (wr == 1) PG8_BAR; }
    }
    PG8_WAIT_V(0);
    if constexpr (!ALIGN_EPI) { if (wr == 0) PG8_BAR; }
    PG8_BAR;
#undef PG8_SA
#undef PG8_SB
#undef PG8_GL
#undef PG8_STAGEA
#undef PG8_STAGEB
#undef PG8_LDA
#undef PG8_LDB
#undef PG8_MMA
#undef PG8_CAT8
#undef PG8_WAIT_V
#undef PG8_WAIT_L
#undef PG8_BAR
#undef PG8_SCHED
}
}

namespace prob {
using pg8::Acc; using pg8::Unit; using pg8::PBase;
__device__ __forceinline__ LAS float* T0(ldsp tab, int par) { return (LAS float*)(tab) + par * 256; }
__device__ __forceinline__ LAS float* T1(ldsp tab, int par) { return (LAS float*)(tab + 2048) + par * 256; }
__device__ __forceinline__ LAS int*   T2(ldsp tab, int par) { return (LAS int*)(tab + 4096) + par * 256; }
__device__ __forceinline__ LAS float* T3(ldsp tab, int par) { return (LAS float*)(tab + 6144) + par * 512; }
__device__ __forceinline__ u32x4 pack8(f32x4 a, f32x4 b) { u32x4 w; w.x = cvt_pk_bf16(a[0], a[1]); w.y = cvt_pk_bf16(a[2], a[3]); w.z = cvt_pk_bf16(b[0], b[1]); w.w = cvt_pk_bf16(b[2], b[3]); return w; }
__device__ __forceinline__ float dot4(f32x4 a) { return (a[0] * a[0] + a[1] * a[1]) + (a[2] * a[2] + a[3] * a[3]); }
__device__ __forceinline__ void rot8(f32x4& x1, f32x4& x2, const float* cosp, const float* sinp) {
    const f32x4 c = gld4(cosp), s = gld4(sinp); const f32x4 a = x1 * c - x2 * s, b = x2 * c + x1 * s; x1 = a; x2 = b; }

#define PROB_WS() unsigned char* w_ = ws; asm volatile("" : "+s"(w_))
struct PIn : PBase {
    static constexpr bool PERM = true;
    unsigned char* ws; int l;
    __device__ __forceinline__ void prepare(const Unit& u, int par, ldsp tab) const {
        PROB_WS(); const float* ssqx = (const float*)(w_ + WS_SSQX);
        const int tid = launder_v(threadIdx.x); if (tid < 256) { const int row = u.pm * 256 + tid; const float bvl = ((const float*)(w_ + WS_BIN))[((size_t)l * 2 + (u.pm >> 5)) * INP + u.pn * 256 + tid];
            T0(tab, par)[tid] = rsq_(sum16(ssqx + (size_t)row * 16) * (1.0f / 1024.0f) + EPS); T3(tab, par)[tid] = bvl; } }
    __device__ __forceinline__ void epi(const Acc& acc, const Unit& u, int par, ldsp tab, int wr, int wc, int fr, int fq) const {
        PROB_WS(); const float* cosT = (const float*)(w_ + WS_COS); const float* sinT = (const float*)(w_ + WS_SIN);
        bf16_t* proj = (bf16_t*)(w_ + WS_PROJ); float* ssql = (float*)(w_ + WS_SSQL);
        const LAS float* bp = T3(tab, par) + wc * 32 + 8 * fq;
        f32x4 bv[2][2];
#pragma unroll
        for (int bj = 0; bj < 2; ++bj)
#pragma unroll
            for (int n = 0; n < 2; ++n) bv[bj][n] = *(const LAS f32x4*)(bp + bj * 128 + 4 * n);
        const bool rope = (u.pn == 1 && wc == 0);
        f32x4 cs8[8], sn8[8];
        if (rope) {
#pragma unroll
            for (int g = 0; g < 8; ++g) { const size_t gr = (size_t)u.pm * 256 + (g >> 2) * 128 + wr * 64 + (g & 3) * 16 + fr; cs8[g] = gld4(cosT + gr * 16 + 4 * fq); sn8[g] = gld4(sinT + gr * 16 + 4 * fq); } }
#pragma unroll
        for (int ai = 0; ai < 2; ++ai)
#pragma unroll
            for (int m = 0; m < 4; ++m) { const int lr = ai * 128 + wr * 64 + m * 16 + fr; const float rs = T0(tab, par)[lr]; const size_t grow = (size_t)u.pm * 256 + lr;
                bf16_t* rowp = proj + grow * INP + u.pn * 256 + wc * 32 + 8 * fq; float s = 0.f;
#pragma unroll
                for (int bj = 0; bj < 2; ++bj) { f32x4 v0 = acc[ai][bj][m][0] * rs + bv[bj][0], v1 = acc[ai][bj][m][1] * rs + bv[bj][1];
                    if (bj == 1 && rope) { const f32x4 c = cs8[ai * 4 + m], s2 = sn8[ai * 4 + m]; const f32x4 a = v0 * c - v1 * s2, b2 = v1 * c + v0 * s2; v0 = a; v1 = b2; }
                    if (u.pn == 0 || bj == 0) s += dot4(v0) + dot4(v1);
                    gst16(rowp + bj * 128, pack8(v0, v1)); }
                if (u.pn <= 1) { s += __shfl_xor(s, 16); s += __shfl_xor(s, 32); if (fq == 0) ssql[grow * 8 + u.pn * 4 + wc] = s; } }
    }
};
struct PQ : PBase {
    static constexpr bool PERM = true;
    unsigned char* ws;
    __device__ __forceinline__ void prepare(const Unit& u, int par, ldsp tab) const {
        PROB_WS(); const float* ssql = (const float*)(w_ + WS_SSQL);
        const int tid = launder_v(threadIdx.x); if (tid < 256) { const int row = u.pm * 256 + tid; const f32x4 a = gld4(ssql + (size_t)row * 8); T0(tab, par)[tid] = rsq_(((a[0] + a[1]) + (a[2] + a[3])) * (1.0f / 256.0f) + EPS); } }
    __device__ __forceinline__ void epi(const Acc& acc, const Unit& u, int par, ldsp tab, int wr, int wc, int fr, int fq) const {
        PROB_WS(); const float* cosT = (const float*)(w_ + WS_COS); const float* sinT = (const float*)(w_ + WS_SIN); bf16_t* q = (bf16_t*)(w_ + WS_QMLA);
        const bool r0 = ((u.pn * 8 + wc) % 3 == 2), r1 = ((u.pn * 8 + 4 + wc) % 3 == 2);
        f32x4 cs8[8], sn8[8];
        if (r0 || r1) {
#pragma unroll
            for (int g = 0; g < 8; ++g) { const size_t gr = (size_t)u.pm * 256 + (g >> 2) * 128 + wr * 64 + (g & 3) * 16 + fr; cs8[g] = gld4(cosT + gr * 16 + 4 * fq); sn8[g] = gld4(sinT + gr * 16 + 4 * fq); } }
#pragma unroll
        for (int ai = 0; ai < 2; ++ai)
#pragma unroll
            for (int m = 0; m < 4; ++m) { const int lr = ai * 128 + wr * 64 + m * 16 + fr; const float rs = T0(tab, par)[lr]; const size_t grow = (size_t)u.pm * 256 + lr;
                bf16_t* rowp = q + grow * QW + u.pn * 256 + wc * 32 + 8 * fq;
#pragma unroll
                for (int bj = 0; bj < 2; ++bj) { f32x4 v0 = acc[ai][bj][m][0] * rs, v1 = acc[ai][bj][m][1] * rs;
                    if (bj == 0 ? r0 : r1) { const f32x4 c = cs8[ai * 4 + m], s2 = sn8[ai * 4 + m]; const f32x4 a = v0 * c - v1 * s2, b2 = v1 * c + v0 * s2; v0 = a; v1 = b2; }
                    gst16(rowp + bj * 128, pack8(v0, v1)); } }
    }
};
struct PKV : PBase {
    static constexpr bool PERM = true;
    unsigned char* ws;
    __device__ __forceinline__ void prepare(const Unit& u, int par, ldsp tab) const {
        PROB_WS(); const float* ssql = (const float*)(w_ + WS_SSQL);
        const int tid = launder_v(threadIdx.x); if (tid < 256) { const int row = u.pm * 256 + tid; const f32x4 a = gld4(ssql + (size_t)row * 8 + 4); T0(tab, par)[tid] = rsq_(((a[0] + a[1]) + (a[2] + a[3])) * (1.0f / 128.0f) + EPS); } }
    __device__ __forceinline__ void epi(const Acc& acc, const Unit& u, int par, ldsp tab, int wr, int wc, int fr, int fq) const {
        PROB_WS(); bf16_t* kv = (bf16_t*)(w_ + WS_KV);
#pragma unroll
        for (int ai = 0; ai < 2; ++ai)
#pragma unroll
            for (int m = 0; m < 4; ++m) { const int lr = ai * 128 + wr * 64 + m * 16 + fr; const float rs = T0(tab, par)[lr]; const size_t grow = (size_t)u.pm * 256 + lr;
                bf16_t* rowp = kv + grow * KVW + u.pn * 256 + wc * 32 + 8 * fq;
#pragma unroll
                for (int bj = 0; bj < 2; ++bj) gst16(rowp + bj * 128, pack8(acc[ai][bj][m][0] * rs, acc[ai][bj][m][1] * rs)); }
    }
};
__device__ __forceinline__ void epi_resid(const Acc& acc, const Unit& u, LAS const float* rsT, bf16_t* X, const float* gate, const float* gsn, bf16_t* anext, bool out8, float* ssqx, int wr, int wc, int fr, int fq) {
    const int b = u.pm >> 5; const int col0 = u.pn * 256 + wc * 32 + 4 * fq;
    float s[8];
#pragma unroll
    for (int j = 0; j < 8; ++j) s[j] = 0.f;
    u32x2 xq[3][4]; f32x4 gtq[2], gnq[2];
#define ER_LOAD(k) do { const int bj_ = (k) >> 2, n_ = ((k) >> 1) & 1, ai_ = (k) & 1; const int co_ = col0 + bj_ * 128 + n_ * 16; \
        _Pragma("unroll") for (int g = 0; g < 4; ++g) xq[(k) % 3][g] = *(const GAS u32x2*)(X + ((size_t)u.pm * 256 + ai_ * 128 + wr * 64 + g * 16 + fr) * 1024 + co_); } while (0)
#define ER_LOADG(k) do { const int co_ = col0 + ((k) >> 2) * 128 + (((k) >> 1) & 1) * 16; gtq[((k) >> 1) & 1] = gld4(gate + b * 1024 + co_); gnq[((k) >> 1) & 1] = gld4(gsn + b * 1024 + co_); } while (0)
    ER_LOADG(0); ER_LOAD(0); ER_LOAD(1); ER_LOADG(2);
#pragma unroll
    for (int k = 0; k < 8; ++k) { const int bj = k >> 2, n = (k >> 1) & 1, ai = k & 1; const int co = col0 + bj * 128 + n * 16;
        if (k + 2 < 8) ER_LOAD(k + 2);
        __builtin_amdgcn_sched_barrier(0);
        const f32x4 gt = gtq[(k >> 1) & 1], gn = gnq[(k >> 1) & 1];
#pragma unroll
        for (int m = 0; m < 4; ++m) { const int lr = ai * 128 + wr * 64 + m * 16 + fr; const float rs = rsT ? rsT[lr] : 1.0f; const size_t off = ((size_t)u.pm * 256 + lr) * 1024 + co;
            const u32x2 xr = xq[k % 3][m]; const f32x4 xo = (f32x4){bf_lo(xr.x), bf_hi(xr.x), bf_lo(xr.y), bf_hi(xr.y)};
            const f32x4 xn = xo + gt * (acc[ai][bj][m][n] * rs);
            { u32x2 wx; wx.x = cvt_pk_bf16(xn[0], xn[1]); wx.y = cvt_pk_bf16(xn[2], xn[3]); gst8(X + off, wx); } s[ai * 4 + m] += dot4(xn);
            const f32x4 a = xn * gn;
            if (out8) *(GAS unsigned*)((unsigned char*)anext + off) = cvt4_fp8(a[0], a[1], a[2], a[3]);
            else { u32x2 w; w.x = cvt_pk_bf16(a[0], a[1]); w.y = cvt_pk_bf16(a[2], a[3]); gst8(anext + off, w); } }
        if ((k & 1) == 1 && k + 3 < 8) ER_LOADG(k + 3);
        __builtin_amdgcn_sched_barrier(0); }
#undef ER_LOAD
#undef ER_LOADG
#pragma unroll
    for (int ai = 0; ai < 2; ++ai)
#pragma unroll
        for (int m = 0; m < 4; ++m) { const int lr = ai * 128 + wr * 64 + m * 16 + fr; float q = s[ai * 4 + m]; q += __shfl_xor(q, 16); q += __shfl_xor(q, 32);
            if (fq == 0) ssqx[((size_t)u.pm * 256 + lr) * 16 + u.pn * 4 + wc] = q; }
}
struct POut : PBase {
    static constexpr bool PERM = false, MIDK = true; static constexpr int MIDT = 8;
    unsigned char* ws; int l; const float* xin0;
    __device__ __forceinline__ void prepare(const Unit& u, int par, ldsp tab) const {
        PROB_WS(); const float* ssqo = (const float*)(w_ + WS_SSQO);
        const int tid = launder_v(threadIdx.x); if (tid < 256) { const float* p = ssqo + ((size_t)u.pm * 256 + tid) * 16; const f32x4 a = gld4(p), b = gld4(p + 4), c = gld4(p + 8), d = gld4(p + 12);
            const float sm = ((a[0] + a[1]) + (a[2] + a[3])) + ((b[0] + b[1]) + (b[2] + b[3])), ss = ((c[0] + c[1]) + (c[2] + c[3])) + ((d[0] + d[1]) + (d[2] + d[3]));
            const float rm = rsq_(sm * (1.0f / 512.0f) + EPS), rsb = rsq_(ss * (1.0f / 512.0f) + EPS);
            T0(tab, par)[tid] = rsb; T1(tab, par)[tid] = rm / rsb; } }
    __device__ __forceinline__ void midscale(Acc& acc, int par, ldsp tab, int wr, int fr) const {
#pragma unroll
        for (int ai = 0; ai < 2; ++ai)
#pragma unroll
            for (int m = 0; m < 4; ++m) { const float f = T1(tab, par)[ai * 128 + wr * 64 + m * 16 + fr];
#pragma unroll
                for (int bj = 0; bj < 2; ++bj)
#pragma unroll
                    for (int n = 0; n < 2; ++n) acc[ai][bj][m][n] = acc[ai][bj][m][n] * f; } }
    __device__ __forceinline__ void epi(const Acc& acc, const Unit& u, int par, ldsp tab, int wr, int wc, int fr, int fq) const {
        PROB_WS(); bf16_t* X = (bf16_t*)(w_ + WS_X); const float* gs = (const float*)(w_ + WS_GS) + (size_t)l * 4 * 2048;
        epi_resid(acc, u, T0(tab, par), X, gs + 1 * 2048, gs + 2 * 2048, (bf16_t*)(w_ + WS_AFFN), (l & 1) != 0, (float*)(w_ + WS_SSQX), wr, wc, fr, fq); }
};
struct PDown : PBase {
    static constexpr bool PERM = false;
    unsigned char* ws; int l;
    __device__ __forceinline__ void prepare(const Unit&, int, ldsp) const {}
    __device__ __forceinline__ void epi(const Acc& acc, const Unit& u, int, ldsp, int wr, int wc, int fr, int fq) const {
        PROB_WS(); bf16_t* X = (bf16_t*)(w_ + WS_X); const float* gs = (const float*)(w_ + WS_GS) + (size_t)l * 4 * 2048;
        epi_resid(acc, u, (LAS const float*)nullptr, X, gs + 3 * 2048, gs + 4 * 2048  , (bf16_t*)(w_ + WS_AMIX), false, (float*)(w_ + WS_SSQX), wr, wc, fr, fq); }
};
struct PGU : PBase {
    static constexpr bool PERM = true;
    unsigned char* ws; int i;
    __device__ __forceinline__ void prepare(const Unit& u, int par, ldsp tab) const {
        PROB_WS(); const float* ssqx = (const float*)(w_ + WS_SSQX);
        const int tid = launder_v(threadIdx.x); if (tid < 256) { const int row = u.pm * 256 + tid; const float bvl = ((const float*)(w_ + WS_BGU))[((size_t)i * 2 + (u.pm >> 5)) * (2 * DFF) + u.pn * 256 + tid];
            T0(tab, par)[tid] = rsq_(sum16(ssqx + (size_t)row * 16) * (1.0f / 1024.0f) + EPS); T3(tab, par)[tid] = bvl; } }
    __device__ __forceinline__ void epi(const Acc& acc, const Unit& u, int par, ldsp tab, int wr, int wc, int fr, int fq) const {
        PROB_WS(); bf16_t* act = (bf16_t*)(w_ + WS_ACT);
        const LAS float* bp = T3(tab, par) + wc * 32 + 8 * fq;
        f32x4 bg[2], bu[2];
#pragma unroll
        for (int n = 0; n < 2; ++n) { bg[n] = *(const LAS f32x4*)(bp + 4 * n); bu[n] = *(const LAS f32x4*)(bp + 128 + 4 * n); }
#pragma unroll
        for (int ai = 0; ai < 2; ++ai)
#pragma unroll
            for (int m = 0; m < 4; ++m) { const int lr = ai * 128 + wr * 64 + m * 16 + fr; const float rs = T0(tab, par)[lr]; const size_t grow = (size_t)u.pm * 256 + lr;
                f32x4 h[2];
#pragma unroll
                for (int n = 0; n < 2; ++n) { const f32x4 g = acc[ai][0][m][n] * rs + bg[n], up = acc[ai][1][m][n] * rs + bu[n];
#pragma unroll
                    for (int j = 0; j < 4; ++j) h[n][j] = silu_(g[j]) * up[j]; }
                gst16(act + grow * DFF + u.pn * 128 + wc * 32 + 8 * fq, pack8(h[0], h[1])); }
    }
};
struct MoeTab { LAS int* p;
    __device__ __forceinline__ int ntiles() const { return p[8]; }
    __device__ __forceinline__ void locate(int pm, int& e, int& lt) const { int ee = 0;
#pragma unroll
        for (int j = 1; j < 8; ++j) ee += (pm >= p[j]) ? 1 : 0;
        e = ee; lt = pm - p[ee]; }
};
struct PEGU : PBase {
    static constexpr bool PERM = true, GATHER = true, FP8 = true;
    MoeTab mt; unsigned char* ws; int i;
    __device__ __forceinline__ const char* b_tile(const Unit& u) const { int e, lt; mt.locate(u.pm, e, lt); return Bt + ((size_t)e * (2 * DFE) + (size_t)u.pn * 256) * 1024; }
    __device__ __forceinline__ void a_offs(const Unit& u, unsigned (&off)[2][2], const int (&sR)[2], const int (&sC)[2]) const { int e, lt; mt.locate(u.pm, e, lt); const int cnt = mt.p[32 + e];
        PROB_WS(); const int* rowtok = (const int*)(w_ + WS_ROWTOK);
#pragma unroll
        for (int h = 0; h < 2; ++h)
#pragma unroll
            for (int i2 = 0; i2 < 2; ++i2) { const int idx = lt * 256 + h * 128 + sR[i2]; const int tok = idx < cnt ? (rowtok[(size_t)e * MT + idx] >> 1) : 0; off[h][i2] = (unsigned)(tok * 512 + sC[i2]) * 2u; } }
    __device__ __forceinline__ void prepare(const Unit& u, int par, ldsp tab) const {
        PROB_WS(); const GAS int* rowtok = (const GAS int*)(w_ + WS_ROWTOK); const GAS float* roww = (const GAS float*)(w_ + WS_ROWW); const GAS float* rowr = (const GAS float*)(w_ + WS_ROWR);
        const int tid = launder_v(threadIdx.x); int e, lt; mt.locate(u.pm, e, lt);
        const GAS float* bias = (const GAS float*)(w_ + WS_BEGU) + ((size_t)i * NE + e) * 2 * (2 * DFE) + (size_t)(tid >> 8) * (2 * DFE) + u.pn * 256;
        const float bv = bias[tid & 255];
        int rt = -1; float r = 0.f, w = 0.f;
        if (tid < 256) { const int idx = lt * 256 + tid; if (idx < mt.p[32 + e]) { const size_t o = (size_t)e * MT + idx; rt = rowtok[o]; r = rowr[o]; w = roww[o]; } }
        T3(tab, par)[tid] = bv;
        if (tid < 256) { T2(tab, par)[tid] = rt; T0(tab, par)[tid] = r * (1.0f / W8_SCALE); T1(tab, par)[tid] = w * H8_SCALE; } }
    __device__ __forceinline__ void epi(const Acc& acc, const Unit& u, int par, ldsp tab, int wr, int wc, int fr, int fq) const {
        PROB_WS(); unsigned char* act = w_ + WS_ACT;
        int e, lt; mt.locate(u.pm, e, lt); const size_t pos0 = (size_t)mt.p[16 + e] + (size_t)lt * 256;
        const LAS float* bpe = T3(tab, par) + wc * 32 + 8 * fq;
#pragma unroll
        for (int ai = 0; ai < 2; ++ai)
#pragma unroll
            for (int m = 0; m < 4; ++m) { const int lr = ai * 128 + wr * 64 + m * 16 + fr; const int rt = T2(tab, par)[lr];
                if (rt >= 0) { const float rs = T0(tab, par)[lr], w = T1(tab, par)[lr]; const LAS float* bp = bpe + (rt >> 14) * 256;
                    f32x4 h[2];
#pragma unroll
                    for (int n = 0; n < 2; ++n) { const f32x4 g = acc[ai][0][m][n] * rs + *(const LAS f32x4*)(bp + 4 * n), up = acc[ai][1][m][n] * rs + *(const LAS f32x4*)(bp + 128 + 4 * n);
#pragma unroll
                        for (int j = 0; j < 4; ++j) h[n][j] = silu_(g[j]) * up[j] * w; }
                    u32x2 o8; o8.x = cvt4_fp8(h[0][0], h[0][1], h[0][2], h[0][3]); o8.y = cvt4_fp8(h[1][0], h[1][1], h[1][2], h[1][3]);
                    gst8(act + (pos0 + lr) * DFE + u.pn * 128 + wc * 32 + 8 * fq, o8); } }
    }
};
struct PED : PBase {
    static constexpr bool PERM = true, FP8 = true;
    MoeTab mt; unsigned char* ws;
    __device__ __forceinline__ const char* a_tile(const Unit& u) const { int e, lt; mt.locate(u.pm, e, lt); return A + ((size_t)mt.p[16 + e] + (size_t)lt * 256) * DFE; }
    __device__ __forceinline__ const char* b_tile(const Unit& u) const { int e, lt; mt.locate(u.pm, e, lt); return Bt + ((size_t)e * 1024 + (size_t)u.pn * 256) * DFE; }
    __device__ __forceinline__ void prepare(const Unit& u, int par, ldsp tab) const {
        PROB_WS(); const int* rowtok = (const int*)(w_ + WS_ROWTOK);
        const int tid = launder_v(threadIdx.x); if (tid < 256) { int e, lt; mt.locate(u.pm, e, lt); const int idx = lt * 256 + tid; T2(tab, par)[tid] = idx < mt.p[32 + e] ? rowtok[(size_t)e * MT + idx] : -1; } }
    __device__ __forceinline__ void epi(const Acc& acc, const Unit& u, int par, ldsp tab, int wr, int wc, int fr, int fq) const {
        PROB_WS(); bf16_t* y = (bf16_t*)(w_ + WS_Y);
#pragma unroll
        for (int ai = 0; ai < 2; ++ai)
#pragma unroll
            for (int m = 0; m < 4; ++m) { const int lr = ai * 128 + wr * 64 + m * 16 + fr; const int rt = T2(tab, par)[lr];
                if (rt >= 0) { bf16_t* rowp = y + (size_t)rt * 1024 + u.pn * 256 + wc * 32 + 8 * fq;
#pragma unroll
                    for (int bj = 0; bj < 2; ++bj) gst16(rowp + bj * 128, pack8(acc[ai][bj][m][0] * (1.0f / (W8_SCALE * H8_SCALE)), acc[ai][bj][m][1] * (1.0f / (W8_SCALE * H8_SCALE)))); } }
    }
};
#undef PROB_WS
}

namespace att {
typedef short v4i16_t __attribute__((ext_vector_type(4)));
__device__ __forceinline__ int crow(int r, int hi) { return (r & 3) + 8 * (r >> 2) + 4 * hi; }
#define ATT_WAITBAR() asm volatile("s_waitcnt vmcnt(0) lgkmcnt(0)\n\ts_barrier" ::: "memory")
__device__ __forceinline__ void glds(const void* g, ldsp l) { __builtin_amdgcn_global_load_lds((const unsigned*)g, (LAS unsigned*)l, 16, 0, 0); }
__device__ __forceinline__ f32x16 mfma32(bf16x8 a, bf16x8 b, f32x16 c) { return __builtin_amdgcn_mfma_f32_32x32x16_bf16(a, b, c, 0, 0, 0); }
__device__ __forceinline__ s16x4 vtr(const LAS unsigned char* p) { return __builtin_bit_cast(s16x4, __builtin_amdgcn_ds_read_tr16_b64_v4i16((LAS v4i16_t*)p)); }
__device__ __forceinline__ float swapmax(float m) { auto rr = __builtin_amdgcn_permlane32_swap(__float_as_uint(m), __float_as_uint(m), false, false); return fmaxf(__uint_as_float(rr[0]), __uint_as_float(rr[1])); }
__device__ __forceinline__ float swapsum(float m) { auto rr = __builtin_amdgcn_permlane32_swap(__float_as_uint(m), __float_as_uint(m), false, false); return __uint_as_float(rr[0]) + __uint_as_float(rr[1]); }
#define ATT_MX3(a, b, c) __builtin_fmaxf(__builtin_fmaxf((a), (b)), (c))
__device__ __forceinline__ float rowmax(const f32x16& p0, const f32x16& p1) {
    float a = ATT_MX3(p0[0], p0[1], p1[0]), b = ATT_MX3(p0[2], p0[3], p1[1]); a = ATT_MX3(a, p1[2], p1[3]);
#pragma unroll
    for (int r = 4; r < 16; r += 4) { a = ATT_MX3(a, p0[r], p0[r + 1]); b = ATT_MX3(b, p0[r + 2], p0[r + 3]); a = ATT_MX3(a, p1[r], p1[r + 1]); b = ATT_MX3(b, p1[r + 2], p1[r + 3]); }
    return swapmax(__builtin_fmaxf(a, b));
}
__device__ __forceinline__ u32x4 packp(const f32x16& p, int b) { u32x4 w; w.x = cvt_pk_bf16(p[b], p[b + 1]); w.y = cvt_pk_bf16(p[b + 2], p[b + 3]); w.z = cvt_pk_bf16(p[b + 4], p[b + 5]); w.w = cvt_pk_bf16(p[b + 6], p[b + 7]); return w; }
__device__ __forceinline__ void pv(f32x16 (&o)[2], const LAS unsigned char* vp, u32x4 pw0, u32x4 pw1, u32x4 pw2, u32x4 pw3) {
#pragma unroll
    for (int d0 = 0; d0 < 2; ++d0) {
        s16x4 lo[4], hi4[4];
#pragma unroll
        for (int ks = 0; ks < 4; ++ks) { lo[ks] = vtr(vp + d0 * 4096 + ks * 1024); hi4[ks] = vtr(vp + d0 * 4096 + ks * 1024 + 512); }
#define ATT_PK(k) (bf16x8){lo[k][0], lo[k][1], lo[k][2], lo[k][3], hi4[k][0], hi4[k][1], hi4[k][2], hi4[k][3]}
        o[d0] = mfma32(__builtin_bit_cast(bf16x8, pw0), ATT_PK(0), o[d0]);
        o[d0] = mfma32(__builtin_bit_cast(bf16x8, pw1), ATT_PK(1), o[d0]);
        o[d0] = mfma32(__builtin_bit_cast(bf16x8, pw2), ATT_PK(2), o[d0]);
        o[d0] = mfma32(__builtin_bit_cast(bf16x8, pw3), ATT_PK(3), o[d0]);
#undef ATT_PK
    }
}
__device__ __forceinline__ void store_o(const f32x16 (&o)[2], const float (&sc)[16], bf16_t* Ow, float* ssq  , ldsp stg, int lane, int r32, int hi) {
    LAS bf16_t* s = (LAS bf16_t*)stg;
#pragma unroll
    for (int r = 0; r < 16; ++r) { const int orow = crow(r, hi);
#pragma unroll
        for (int d0 = 0; d0 < 2; ++d0) s[orow * 64 + d0 * 32 + r32] = (bf16_t)(cvt_pk_bf16(o[d0][r] * sc[r], 0.f) & 0xffffu); }
    asm volatile("s_waitcnt lgkmcnt(0)" ::: "memory");
#pragma unroll
    for (int i = 0; i < 4; ++i) { const int row = i * 8 + (lane >> 3), ch = lane & 7; const u32x4 v = *(const LAS u32x4*)(s + row * 64 + ch * 8);
        gst16(Ow + (size_t)row * 1024 + ch * 8, v);
        float q = 0.f;
#pragma unroll
        for (int j = 0; j < 4; ++j) { const float a = bf_lo(v[j]), b = bf_hi(v[j]); q += a * a + b * b; }
        q += __shfl_xor(q, 1); q += __shfl_xor(q, 2); q += __shfl_xor(q, 4);
        if (ch == 0) ssq[(size_t)row * 16] = q; }
}
constexpr int KS_MLA = 12288, NRING = 4, VOFF = NRING * KS_MLA, VS = 8192, WSF_OFF = VOFF + NRING * VS, OST_OFF = WSF_OFF + 8 * 256, ATT_LDS = OST_OFF + 8 * 4096;
static_assert(ATT_LDS <= RING_BYTES, "attention LDS");

#define SGB(mask, n) __builtin_amdgcn_sched_group_barrier(mask, n, 0)
__device__ __forceinline__ void mla_unit(int b, int h, int qb, const bf16_t* __restrict__ Q, const bf16_t* __restrict__ KV, const bf16_t* __restrict__ PROJ, bf16_t* OCAT, float* SSQO, ldsp shm) {
    const int tid = launder_v(threadIdx.x), lane = tid & 63, r32 = lane & 31, hi = lane >> 5; const int wid = __builtin_amdgcn_readfirstlane(tid >> 6);
    const size_t rowbase = (size_t)b * SEQ; const int q0 = qb * 256;
    const bf16_t* ksrc = KV + (rowbase + lane) * KVW + h * 128 + wid * 8;
    const bf16_t* rsrc = PROJ + (rowbase + lane) * INP + 384 + (wid & 3) * 8;
    const bf16_t* vsrc = KV + (rowbase + 16 * (wid & 3) + (lane >> 2)) * KVW + h * 128 + 64 + (wid >> 2) * 32 + (lane & 3) * 8;
    const int NT = 4 * qb + 4, NTw = 4 * qb + 1 + (wid >> 1);
#define MLA_DMAK(t, s) do { glds(ksrc + (size_t)(t) * 64 * KVW, shm + (s) * KS_MLA + wid * 1024); if (wid < 4) glds(rsrc + (size_t)(t) * 64 * INP, shm + (s) * KS_MLA + (8 + wid) * 1024); } while (0)
#define MLA_DMAV(t, s) glds(vsrc + (size_t)(t) * 64 * KVW, shm + VOFF + (s) * VS + wid * 1024)
#define MLA_WAITBAR() do { if (wid < 4) asm volatile("s_waitcnt vmcnt(6) lgkmcnt(0)\n\ts_barrier" ::: "memory"); else asm volatile("s_waitcnt vmcnt(4) lgkmcnt(0)\n\ts_barrier" ::: "memory"); } while (0)
#define MLA_ISSUE(s) do { const int tk_ = (s) + 3 < NT - 1 ? (s) + 3 : NT - 1, tv_ = (s) + 2 < 0 ? 0 : ((s) + 2 < NT - 1 ? (s) + 2 : NT - 1); MLA_DMAK(tk_, ((s) + 3) & 3); MLA_DMAV(tv_, ((s) + 2) & 3); } while (0)
    MLA_ISSUE(-3); MLA_ISSUE(-2); MLA_ISSUE(-1);
    bf16x8 qr[6];
    { const bf16_t* Qw = Q + (rowbase + q0 + wid * 32 + r32) * QW + h * 96 + hi * 8;
#pragma unroll
      for (int d0 = 0; d0 < 6; ++d0) qr[d0] = *(const GAS bf16x8*)(Qw + d0 * 16); }
    asm volatile("s_waitcnt vmcnt(0)" ::: "memory");
    LAS float* wsf = (LAS float*)(shm + WSF_OFF) + wid * 64;
    const LAS unsigned char* vp0 = shm + VOFF + ((lane >> 4) & 1) * 32 + (lane & 3) * 8 + (4 * hi + ((lane & 15) >> 2)) * 64;
    const LAS unsigned char* kp0 = shm + hi * 1024 + r32 * 16;
    float mhat = 0.f, l_reg = 0.f; f32x16 o[2]; o[0] = f32x16{}; o[1] = f32x16{}; f32x16 negm = f32x16{};
    f32x16 pA0, pA1, pB0, pB1;
#define SBAR() __builtin_amdgcn_sched_barrier(0)
#define PIN(x) asm volatile("" : "+v"(x))
    MLA_WAITBAR();
    MLA_ISSUE(0);
    { const LAS unsigned char* kb = kp0; pA0 = f32x16{}; pA1 = f32x16{};
#pragma unroll
      for (int d0 = 0; d0 < 6; ++d0) { const bf16x8 k0 = *(const LAS bf16x8*)(kb + d0 * 2048), k1 = *(const LAS bf16x8*)(kb + d0 * 2048 + 512); pA0 = mfma32(k0, qr[d0], pA0); pA1 = mfma32(k1, qr[d0], pA1); }
      mhat = rowmax(pA0, pA1);
#pragma unroll
      for (int r = 0; r < 16; ++r) { negm[r] = -mhat; pA0[r] = ex2(pA0[r] - mhat); pA1[r] = ex2(pA1[r] - mhat); } }
    PIN(negm);
#define KRD(i) kf[i] = *(const LAS bf16x8*)(kb + ((i) >> 1) * 2048 + ((i) & 1) * 512)
#define VRD(i) do { vlo[i] = vtr(vp + ((i) >> 2) * 4096 + ((i) & 3) * 1024); vhi[i] = vtr(vp + ((i) >> 2) * 4096 + ((i) & 3) * 1024 + 512); } while (0)
#define MLA_VF(i) (bf16x8){vlo[i][0], vlo[i][1], vlo[i][2], vlo[i][3], vhi[i][0], vhi[i][1], vhi[i][2], vhi[i][3]}
#define GAPA(MF, LD, a0, a1, a2, a3, W0, W1, PW) do { MF; LD; sacc += a0; sacc += a1; sacc += a2; sacc += a3; PIN(sacc); W0; W1; PIN(PW); SBAR(); } while (0)
#define GAPB(MF, X, q) do { MF; X[q] = ex2(X[q]); X[(q) + 1] = ex2(X[(q) + 1]); X[(q) + 2] = ex2(X[(q) + 2]); X[(q) + 3] = ex2(X[(q) + 3]); PIN(X); SBAR(); } while (0)
#define PKW(P, q) cvt_pk_bf16(P[q], P[(q) + 1])
#define PAF(w) __builtin_bit_cast(bf16x8, w)
#define STEP(C0, C1, P0, P1, t) do { \
        MLA_WAITBAR(); MLA_ISSUE(t); \
        const LAS unsigned char* kb = kp0 + ((t) & 3) * KS_MLA; const LAS unsigned char* vp = vp0 + (((t) - 1) & 3) * VS; \
        bf16x8 kf[12]; s16x4 vlo[8], vhi[8]; u32x4 pw0, pw1, pw2, pw3; \
        SBAR(); KRD(0); KRD(1); KRD(2); KRD(3); SBAR(); \
        float sacc = P0[0] + P0[1]; \
        GAPA(C0 = mfma32(kf[0], qr[0], negm), do { KRD(4); VRD(0); } while (0), P0[2], P0[3], P0[4], P0[5],       pw0.x = PKW(P0, 0),  pw0.y = PKW(P0, 2),  pw0); \
        GAPA(C1 = mfma32(kf[1], qr[0], negm), do { KRD(5); VRD(4); } while (0), P0[6], P0[7], P0[8], P0[9],       pw0.z = PKW(P0, 4),  pw0.w = PKW(P0, 6),  pw0); \
        GAPA(C0 = mfma32(kf[2], qr[1], C0),   do { KRD(6); VRD(1); } while (0), P0[10], P0[11], P0[12], P0[13],   pw1.x = PKW(P0, 8),  pw1.y = PKW(P0, 10), pw1); \
        GAPA(C1 = mfma32(kf[3], qr[1], C1),   do { KRD(7); VRD(5); } while (0), P0[14], P0[15], P1[0], P1[1],     pw1.z = PKW(P0, 12), pw1.w = PKW(P0, 14), pw1); \
        GAPA(C0 = mfma32(kf[4], qr[2], C0),   do { KRD(8); VRD(2); } while (0), P1[2], P1[3], P1[4], P1[5],       pw2.x = PKW(P1, 0),  pw2.y = PKW(P1, 2),  pw2); \
        GAPA(C1 = mfma32(kf[5], qr[2], C1),   do { KRD(9); VRD(6); } while (0), P1[6], P1[7], P1[8], P1[9],       pw2.z = PKW(P1, 4),  pw2.w = PKW(P1, 6),  pw2); \
        GAPA(C0 = mfma32(kf[6], qr[3], C0),   do { KRD(10); VRD(3); } while (0), P1[10], P1[11], P1[12], P1[13],  pw3.x = PKW(P1, 8),  pw3.y = PKW(P1, 10), pw3); \
        GAPA(C1 = mfma32(kf[7], qr[3], C1),   do { KRD(11); VRD(7); } while (0), P1[14], P1[15], 0.f, 0.f,        pw3.z = PKW(P1, 12), pw3.w = PKW(P1, 14), pw3); \
        C0 = mfma32(kf[8], qr[4], C0); SBAR(); C1 = mfma32(kf[9], qr[4], C1); SBAR(); C0 = mfma32(kf[10], qr[5], C0); SBAR(); C1 = mfma32(kf[11], qr[5], C1); SBAR(); \
        l_reg += sacc; \
        if (__builtin_expect((t) >= NTw, 0)) { asm volatile("" ::: "memory"); _Pragma("unroll") for (int r = 0; r < 16; ++r) { C0[r] = -INFINITY; C1[r] = -INFINITY; } PIN(C0); PIN(C1); } \
        bool resc = false; \
        { const float rm = rowmax(C0, C1); \
          if (__builtin_expect(__any(rm > 8.0f), 0)) { const float dl = fmaxf(rm, 0.f); mhat += dl; \
              _Pragma("unroll") for (int r = 0; r < 16; ++r) { C0[r] -= dl; C1[r] -= dl; negm[r] = -mhat; } PIN(negm); \
              const float f = ex2(-dl); l_reg *= f; if (hi == 0) wsf[r32] = f; resc = true; } } \
        SBAR(); \
        GAPB(o[0] = mfma32(PAF(pw0), MLA_VF(0), o[0]), C0, 0); \
        GAPB(o[1] = mfma32(PAF(pw0), MLA_VF(4), o[1]), C0, 4); \
        GAPB(o[0] = mfma32(PAF(pw1), MLA_VF(1), o[0]), C0, 8); \
        GAPB(o[1] = mfma32(PAF(pw1), MLA_VF(5), o[1]), C0, 12); \
        GAPB(o[0] = mfma32(PAF(pw2), MLA_VF(2), o[0]), C1, 0); \
        GAPB(o[1] = mfma32(PAF(pw2), MLA_VF(6), o[1]), C1, 4); \
        GAPB(o[0] = mfma32(PAF(pw3), MLA_VF(3), o[0]), C1, 8); \
        GAPB(o[1] = mfma32(PAF(pw3), MLA_VF(7), o[1]), C1, 12); \
        if (resc) { asm volatile("s_waitcnt lgkmcnt(0)" ::: "memory"); \
            _Pragma("unroll") for (int r = 0; r < 16; ++r) { const float fr_ = wsf[crow(r, hi)]; o[0][r] *= fr_; o[1][r] *= fr_; } } \
    } while (0)
    int t = 1;
    for (; t + 1 < NT; t += 2) { STEP(pB0, pB1, pA0, pA1, t); STEP(pA0, pA1, pB0, pB1, t + 1); }
    STEP(pB0, pB1, pA0, pA1, t);
    { float sacc = 0.f;
#pragma unroll
      for (int r = 0; r < 16; ++r) sacc += pB0[r] + pB1[r];
      l_reg += sacc;
      ATT_WAITBAR();
      pv(o, vp0 + ((NT - 1) & 3) * VS, packp(pB0, 0), packp(pB0, 8), packp(pB1, 0), packp(pB1, 8)); }
#undef STEP
#undef GAPA
#undef GAPB
#undef PKW
#undef PAF
#undef KRD
#undef VRD
#undef SBAR
#undef PIN
#undef MLA_VF
#undef MLA_DMAK
#undef MLA_DMAV
#undef MLA_WAITBAR
#undef MLA_ISSUE
    l_reg = swapsum(l_reg);
    if (hi == 0) wsf[32 + r32] = l_reg;
    asm volatile("s_waitcnt lgkmcnt(0)" ::: "memory");
    float sc[16];
#pragma unroll
    for (int r = 0; r < 16; ++r) sc[r] = rcpf_(wsf[32 + crow(r, hi)]);
    const size_t row0 = rowbase + q0 + wid * 32;
    store_o(o, sc, OCAT + row0 * 1024 + h * 64, SSQO + row0 * 16 + h, shm + OST_OFF + wid * 4096, lane, r32, hi);
    ATT_WAITBAR();
}
#undef SGB

constexpr int KS_SB = 8192, SB_VOFF = 4 * KS_SB, SB_OST = SB_VOFF + 4 * VS;
__device__ __forceinline__ void sb_unit(int b, int h, int qb, const bf16_t* __restrict__ PROJ, bf16_t* OCAT, float* SSQO, ldsp shm, volatile LAS unsigned* FL) {
    const int tid = launder_v(threadIdx.x), lane = tid & 63, r32 = lane & 31, hi = lane >> 5; const int wid = __builtin_amdgcn_readfirstlane(tid >> 6);
    const size_t rowbase = (size_t)b * SEQ; const int q0 = qb * 256;
    const bf16_t* ksrc = PROJ + (rowbase + lane) * INP + 1024 + h * 64 + wid * 8;
    const bf16_t* vsrc = PROJ + (rowbase + 16 * (wid & 3) + (lane >> 2)) * INP + 1536 + h * 64 + (wid >> 2) * 32 + (lane & 3) * 8;
    const int tmax = 4 * qb + 3, tdw = 4 * qb + (wid >> 1);
#define SB_DMA(t, s) do { glds(ksrc + (size_t)(t) * 64 * INP, shm + (s) * KS_SB + wid * 1024); glds(vsrc + (size_t)(t) * 64 * INP, shm + SB_VOFF + (s) * VS + wid * 1024); } while (0)
    if (tid == 0) { FL[0] = 0u; FL[1] = 0u; FL[2] = 0u; }
#define SB_TILE(s) ((tmax - (s)) > 0 ? (tmax - (s)) : 0)
#define SB_WAITBAR() asm volatile("s_waitcnt vmcnt(4) lgkmcnt(0)\n\ts_barrier" ::: "memory")
    SB_DMA(SB_TILE(0), 0); SB_DMA(SB_TILE(1), 1); SB_DMA(SB_TILE(2), 2);
    bf16x8 qr[4];
    { const bf16_t* Qw = PROJ + (rowbase + q0 + wid * 32 + r32) * INP + 512 + h * 64 + hi * 8;
#pragma unroll
      for (int d0 = 0; d0 < 4; ++d0) qr[d0] = *(const GAS bf16x8*)(Qw + d0 * 16); }
    bf16x8 Ta, Tb, Ton;
#pragma unroll
    for (int j = 0; j < 8; ++j) { const int key = (j < 4) ? 4 * hi + j : 8 + 4 * hi + (j - 4); Ta[j] = (key > r32) ? (short)0x3F80 : (short)0; Tb[j] = (key + 16 > r32) ? (short)0x3F80 : (short)0; Ton[j] = (short)0x3F80; }
    const LAS unsigned char* vp0 = shm + SB_VOFF + ((lane >> 4) & 1) * 32 + (lane & 3) * 8 + (4 * hi + ((lane & 15) >> 2)) * 64;
    const int qabs = q0 + wid * 32 + r32;
    float Lc = 0.f; bool wfin = false; f32x16 o[2]; o[0] = f32x16{}; o[1] = f32x16{};
    int step = 0;
    for (int t = tmax; t >= 0; --t, ++step) {
        SB_WAITBAR();
        if (step > 0) { if (FL[(step - 1) % 3] == 0xFFu) break; }
        if (tid == 0) FL[(step + 1) % 3] = 0u;
        SB_DMA(SB_TILE(step + 3), (step + 3) & 3);
        if (t <= tdw && !wfin) {
            const LAS unsigned char* kb = shm + (step & 3) * KS_SB + hi * 1024 + r32 * 16;
            f32x16 z0 = f32x16{}, z1 = f32x16{};
#pragma unroll
            for (int d0 = 0; d0 < 4; ++d0) { const bf16x8 k0 = *(const LAS bf16x8*)(kb + d0 * 2048), k1 = *(const LAS bf16x8*)(kb + d0 * 2048 + 512);
                z0 = mfma32(k0, qr[d0], z0); z1 = mfma32(k1, qr[d0], z1); }
            const bool diag = (t == tdw); const int kb0 = t * 64 + 4 * hi;
            f32x16 l0, l1; float tot = 0.f;
#pragma unroll
            for (int r = 0; r < 16; ++r) { l0[r] = -lg2(1.0f + ex2(fminf(z0[r], 100.f))); l1[r] = -lg2(1.0f + ex2(fminf(z1[r], 100.f))); }
            if (diag) {
#pragma unroll
                for (int r = 0; r < 16; ++r) { const int kk = kb0 + (r & 3) + 8 * (r >> 2); if (kk >= qabs) l0[r] = 0.f; if (kk + 32 >= qabs) l1[r] = 0.f; } }
#pragma unroll
            for (int r = 0; r < 16; ++r) { tot += l0[r] + l1[r]; z0[r] += l0[r]; z1[r] += l1[r]; }
            u32x4 lh[4];
#pragma unroll
            for (int k = 0; k < 4; ++k)
#pragma unroll
                for (int j = 0; j < 4; ++j) { const float a = (k < 2) ? l0[(k & 1) * 8 + 2 * j] : l1[(k & 1) * 8 + 2 * j], c = (k < 2) ? l0[(k & 1) * 8 + 2 * j + 1] : l1[(k & 1) * 8 + 2 * j + 1];
                    lh[k][j] = cvt_pk_bf16(a, c); }
#define SB_B(x) __builtin_bit_cast(bf16x8, x)
            f32x16 x0, x1;
#pragma unroll
            for (int r = 0; r < 16; ++r) { x0[r] = Lc; x1[r] = Lc; }
            x0 = mfma32(Ta, SB_B(lh[0]), x0); x0 = mfma32(Tb, SB_B(lh[1]), x0); x0 = mfma32(Ton, SB_B(lh[2]), x0); x0 = mfma32(Ton, SB_B(lh[3]), x0);
            x1 = mfma32(Ta, SB_B(lh[2]), x1); x1 = mfma32(Tb, SB_B(lh[3]), x1);
#undef SB_B
#pragma unroll
            for (int r = 0; r < 16; ++r) { z0[r] = ex2(z0[r] + x0[r]); z1[r] = ex2(z1[r] + x1[r]); }
            if (diag) {
#pragma unroll
                for (int r = 0; r < 16; ++r) { const int kk = kb0 + (r & 3) + 8 * (r >> 2); if (kk >= qabs) z0[r] = 0.f; if (kk + 32 >= qabs) z1[r] = 0.f; } }
            pv(o, vp0 + (step & 3) * VS, packp(z0, 0), packp(z0, 8), packp(z1, 0), packp(z1, 8));
            Lc += swapsum(tot);
            wfin = __all(Lc <= SB_DONE) != 0;
        }
        if (t == 0) wfin = true;
        if (wfin && lane == 0) __hip_atomic_fetch_or((LAS unsigned*)&FL[step % 3], 1u << wid, __ATOMIC_RELAXED, __HIP_MEMORY_SCOPE_WORKGROUP);
    }
#undef SB_DMA
#undef SB_TILE
#undef SB_WAITBAR
    asm volatile("s_waitcnt vmcnt(0)" ::: "memory");
    float sc[16];
#pragma unroll
    for (int r = 0; r < 16; ++r) sc[r] = 1.0f;
    const size_t row0 = rowbase + q0 + wid * 32;
    store_o(o, sc, OCAT + row0 * 1024 + 512 + h * 64, SSQO + row0 * 16 + 8 + h, shm + SB_OST + wid * 4096, lane, r32, hi);
    ATT_WAITBAR();
}
__device__ __forceinline__ bool att_next(int i, int vcu, int G, int& bh, int& qb) { const int j = i * G + vcu; if (j >= 512) return false; const int jj = j & 255; bh = jj >> 4; qb = (j < 256) ? (jj & 15) : 31 - (jj & 15); return true; }
}

struct In {
    const float* x; const float* c; const int* pos; const float* w_ada; const float* b_ada; const float* g_mix; const float* g_ffn; const float* w_in;
    const float* g_q_lat; const float* w_uq; const float* g_kv_lat; const float* w_ukv; const float* g_grp_mla; const float* g_grp_sb; const float* w_out;
    const float* w_ff_gate; const float* w_ff_up; const float* w_ff_down; const float* w_router; const float* b_router; const float* w_ex_gate; const float* w_ex_up; const float* w_ex_down; const float* g_final;
};
struct Args { const void* in[24]; float* out; unsigned char* ws; int lo, hi; };

__device__ __forceinline__ void p0a_mod(const In& I, float* mod, ldsp lds) {
    const int tid = threadIdx.x; LAS float* ca = (LAS float*)lds; LAS f32x4* red = (LAS f32x4*)(lds + 8192);
    { const f32x4 v = gld4(I.c + tid * 4); f32x4 sv;
#pragma unroll
      for (int j = 0; j < 4; ++j) sv[j] = v[j] / (1.0f + __expf(-v[j]));
      *(LAS f32x4*)(ca + tid * 4) = sv; }
    __syncthreads();
    const int c4 = tid & 31, kq = tid >> 5;
    for (int it = blockIdx.x; it < NL * 48; it += gridDim.x) {
        const int l = it / 48, n = (it % 48) * 128 + c4 * 4; const float* w = I.w_ada + (size_t)l * 1024 * 6144 + (size_t)(kq * 64) * 6144 + n;
        f32x4 a0 = {0.f, 0.f, 0.f, 0.f}, a1 = {0.f, 0.f, 0.f, 0.f};
        f32x4 wv[8], wn[8];
#pragma unroll
        for (int j = 0; j < 8; ++j) wv[j] = gld4_nt(w + (size_t)j * 6144);
#pragma unroll 1
        for (int k0 = 0; k0 < 64; k0 += 8) {
            if (k0 + 8 < 64) {
#pragma unroll
                for (int j = 0; j < 8; ++j) wn[j] = gld4_nt(w + (size_t)(k0 + 8 + j) * 6144); }
#pragma unroll
            for (int j = 0; j < 8; ++j) { a0 += wv[j] * ca[kq * 64 + k0 + j]; a1 += wv[j] * ca[1024 + kq * 64 + k0 + j]; }
#pragma unroll
            for (int j = 0; j < 8; ++j) wv[j] = wn[j]; }
        red[(0 * 16 + kq) * 32 + c4] = a0; red[(1 * 16 + kq) * 32 + c4] = a1;
        __syncthreads();
        if (tid < 64) { const int b = tid >> 5; f32x4 s = {0.f, 0.f, 0.f, 0.f};
#pragma unroll
            for (int j = 0; j < 16; ++j) s += red[(b * 16 + j) * 32 + c4];
            gst4(mod + ((size_t)l * 2 + b) * 6144 + n, s + gld4(I.b_ada + (size_t)l * 6144 + n)); }
        __syncthreads();
    }
}

__device__ __forceinline__ void conv_wave(const float* src  , int srcN, int Ksrc, float nsc, const float* ks0, const float* ks1,
                                          int kb_lo, int kb_hi, unsigned char* dst, int ldk  , int n0, bool out8, const LAS float* shl, float* bias0, float* bias1, LAS float* scr, int lane) {
    const int nl = lane & 31, kh = lane >> 5; float b0 = 0.f, b1 = 0.f;
    for (int kb = kb_lo; kb < kb_hi; ++kb) { const int k0 = kb * 64;
        float w[32];
#pragma unroll
        for (int i = 0; i < 32; ++i) { const int k = k0 + 2 * i + kh; w[i] = (src != nullptr && k < Ksrc) ? __builtin_nontemporal_load((const GAS float*)(src + (size_t)k * srcN)) : 0.f; }
        if (ks0) {
#pragma unroll
            for (int i = 0; i < 32; ++i) { const int k = k0 + 2 * i + kh; if (k < Ksrc) w[i] *= (ks1 && k >= 512) ? ks1[k - 512] : ks0[k]; } }
#pragma unroll
        for (int i = 0; i < 32; ++i) { w[i] *= nsc; scr[(2 * i + kh) * 33 + nl] = w[i]; }
        if (shl) {
#pragma unroll
            for (int i = 0; i < 32; ++i) { const int k = k0 + 2 * i + kh; b0 += shl[k] * w[i]; b1 += shl[1024 + k] * w[i]; } }
        asm volatile("s_waitcnt lgkmcnt(0)" ::: "memory");
        if (!out8) { const int c = lane & 7;
#pragma unroll
            for (int j = 0; j < 4; ++j) { const int n = (lane >> 3) + 8 * j; const LAS float* s = scr + (8 * c) * 33 + n;
                u32x4 o; o.x = cvt_pk_bf16(s[0 * 33], s[1 * 33]); o.y = cvt_pk_bf16(s[2 * 33], s[3 * 33]); o.z = cvt_pk_bf16(s[4 * 33], s[5 * 33]); o.w = cvt_pk_bf16(s[6 * 33], s[7 * 33]);
                gst16((bf16_t*)dst + (size_t)(n0 + n) * ldk + k0 + 8 * c, o); } }
        else { const int c = lane & 3;
#pragma unroll
            for (int j = 0; j < 2; ++j) { const int n = (lane >> 2) + 16 * j; const LAS float* s = scr + (16 * c) * 33 + n;
                u32x4 o; o.x = cvt4_fp8(s[0 * 33] * W8_SCALE, s[1 * 33] * W8_SCALE, s[2 * 33] * W8_SCALE, s[3 * 33] * W8_SCALE); o.y = cvt4_fp8(s[4 * 33] * W8_SCALE, s[5 * 33] * W8_SCALE, s[6 * 33] * W8_SCALE, s[7 * 33] * W8_SCALE);
                o.z = cvt4_fp8(s[8 * 33] * W8_SCALE, s[9 * 33] * W8_SCALE, s[10 * 33] * W8_SCALE, s[11 * 33] * W8_SCALE); o.w = cvt4_fp8(s[12 * 33] * W8_SCALE, s[13 * 33] * W8_SCALE, s[14 * 33] * W8_SCALE, s[15 * 33] * W8_SCALE);
                gst16(dst + (size_t)(n0 + n) * ldk + k0 + 16 * c, o); } }
        asm volatile("s_waitcnt lgkmcnt(0)" ::: "memory");
    }
    if (shl) { b0 += __shfl_xor(b0, 32); b1 += __shfl_xor(b1, 32); if (lane < 32) { bias0[n0 + nl] = b0; bias1[n0 + nl] = b1; } }
}
constexpr int CI_EGU = 16 * 224, CI_ED = 16 * 32 * 4, CI_WGU = 2 * 160, CI_WD = 2 * 32 * 3, CI_WIN = 4 * 64, CI_WOUT = 4 * 32, CI_WUQ = 4 * 24, CI_WUKV = 4 * 32;
constexpr int N_CITEMS = CI_EGU + CI_ED + CI_WGU + CI_WD + CI_WIN + CI_WOUT + CI_WUQ + CI_WUKV;
constexpr int CI_SKIP = CI_EGU + CI_ED + CI_WGU + CI_WD;
__device__ __forceinline__ void conv_item(const In& I, unsigned char* ws, int it, const LAS float* shl_all  , LAS float* scr, int lane) {
    const int nl = lane & 31; int r = it;
    if (r < CI_EGU) { const int m = r / 224, st = r % 224, i = m >> 3, np = st * 32 + nl, tl = np >> 8, w = np & 255; const size_t so = (size_t)m * 1024 * DFE;
        const float* src = (w < 128 ? I.w_ex_gate : I.w_ex_up) + so + tl * 128 + (w & 127);
        conv_wave(src, DFE, 1024, 1.0f, nullptr, nullptr, 0, 16, ws + WS_EGU + (size_t)m * (2 * DFE) * 1024, 1024, st * 32, true, shl_all + ((2 * i + 1) * 2 + 1) * 2048,
                  (float*)(ws + WS_BEGU) + ((size_t)m * 2 + 0) * (2 * DFE), (float*)(ws + WS_BEGU) + ((size_t)m * 2 + 1) * (2 * DFE), scr, lane); return; }
    r -= CI_EGU;
    if (r < CI_ED) { const int m = r >> 7, st = (r & 127) >> 2, kp = r & 3;
        conv_wave(I.w_ex_down + (size_t)m * DFE * 1024 + st * 32 + nl, 1024, DFE, 1.0f, nullptr, nullptr, kp * 14, kp * 14 + 14, ws + WS_ED + (size_t)m * 1024 * DFE, DFE, st * 32, true, nullptr, nullptr, nullptr, scr, lane); return; }
    r -= CI_ED;
    if (r < CI_WGU) { const int i = r / 160, st = r % 160, np = st * 32 + nl, tl = np >> 8, w = np & 255;
        const float* src = (w < 128 ? I.w_ff_gate : I.w_ff_up) + (size_t)i * 1024 * DFF + tl * 128 + (w & 127);
        conv_wave(src, DFF, 1024, 1.0f, nullptr, nullptr, 0, 16, ws + WS_WGU + (size_t)i * (2 * DFF) * 1024 * 2, 1024, st * 32, false, shl_all + ((2 * i) * 2 + 1) * 2048,
                  (float*)(ws + WS_BGU) + ((size_t)i * 2 + 0) * (2 * DFF), (float*)(ws + WS_BGU) + ((size_t)i * 2 + 1) * (2 * DFF), scr, lane); return; }
    r -= CI_WGU;
    if (r < CI_WD) { const int i = r / 96, st = (r % 96) / 3, kp = r % 3; const int lo = kp == 0 ? 0 : (kp == 1 ? 14 : 27), hi = kp == 0 ? 14 : (kp == 1 ? 27 : 40);
        conv_wave(I.w_ff_down + (size_t)i * DFF * 1024 + st * 32 + nl, 1024, DFF, 1.0f, nullptr, nullptr, lo, hi, ws + WS_WD + (size_t)i * 1024 * DFF * 2, DFF, st * 32, false, nullptr, nullptr, nullptr, scr, lane); return; }
    r -= CI_WD;
    if (r < CI_WIN) { const int l = r >> 6, st = r & 63, np = st * 32 + nl; const float* W0 = I.w_in + (size_t)l * 1024 * INC; const float* src; float nsc = 1.0f;
        if (np < 384) src = W0 + np; else if (np < 416) src = W0 + 384 + ropedim(np - 384); else if (np < 512) src = nullptr; else if (np < 1024) { src = W0 + 416 + (np - 512); nsc = C2S; } else src = W0 + 928 + (np - 1024);
        conv_wave(src, INC, 1024, nsc, nullptr, nullptr, 0, 16, ws + WS_WIN + (size_t)l * INP * 1024 * 2, 1024, st * 32, false, shl_all + (l * 2 + 0) * 2048,
                  (float*)(ws + WS_BIN) + ((size_t)l * 2 + 0) * INP, (float*)(ws + WS_BIN) + ((size_t)l * 2 + 1) * INP, scr, lane); return; }
    r -= CI_WIN;
    if (r < CI_WOUT) { const int l = r >> 5, st = r & 31;
        conv_wave(I.w_out + (size_t)l * 1024 * 1024 + st * 32 + nl, 1024, 1024, 1.0f, I.g_grp_mla + l * 512, I.g_grp_sb + l * 512, 0, 16, ws + WS_WOUT + (size_t)l * 1024 * 1024 * 2, 1024, st * 32, false, nullptr, nullptr, nullptr, scr, lane); return; }
    r -= CI_WOUT;
    if (r < CI_WUQ) { const int l = r / 24, st = r % 24, np = st * 32 + nl, hh = np / 96, w = np % 96;
        conv_wave(I.w_uq + (size_t)l * 256 * QW + hh * 96 + (w < 64 ? w : 64 + ropedim(w - 64)), QW, 256, C2Q, I.g_q_lat + l * 256, nullptr, 0, 4, ws + WS_WUQ + (size_t)l * QW * 256 * 2, 256, st * 32, false, nullptr, nullptr, nullptr, scr, lane); return; }
    r -= CI_WUQ;
    { const int l = r >> 5, st = r & 31;
      conv_wave(I.w_ukv + (size_t)l * 128 * KVW + st * 32 + nl, KVW, 128, 1.0f, I.g_kv_lat + l * 128, nullptr, 0, 4, ws + WS_WUKV + (size_t)l * KVW * 256 * 2, 256, st * 32, false, nullptr, nullptr, nullptr, scr, lane); }
}
template <bool OUT8> __device__ __forceinline__ void conv_wide(const float* W0, const float* W1, int srcN, const float* ks0, const float* ks1, int kb_lo, int kb_hi,
                                                               unsigned char* dst, int ldk  , int n0, const LAS float* shl, float* bias0, float* bias1, ldsp lds) {
    const int tid = threadIdx.x, lane = tid & 63, wid = __builtin_amdgcn_readfirstlane(tid >> 6);
    constexpr int RS = OUT8 ? 72 : 136;
    LAS unsigned char* tile = lds; LAS float* red = (LAS float*)(lds + 256 * 136);
    const float* src = (W1 != nullptr && lane >= 32) ? W1 + 4 * (lane - 32) : W0 + 4 * lane;
    f32x4 v[8], vn[8]; f32x4 b0 = {0.f, 0.f, 0.f, 0.f}, b1 = {0.f, 0.f, 0.f, 0.f};
#pragma unroll
    for (int j = 0; j < 8; ++j) v[j] = gld4_nt(src + (size_t)(kb_lo * 64 + 8 * wid + j) * srcN);
    for (int kb = kb_lo; kb < kb_hi; ++kb) { const int k0 = kb * 64 + 8 * wid;
        if (kb + 1 < kb_hi) {
#pragma unroll
            for (int j = 0; j < 8; ++j) vn[j] = gld4_nt(src + (size_t)(k0 + 64 + j) * srcN); }
        if (ks0) {
#pragma unroll
            for (int j = 0; j < 8; ++j) { const int k = k0 + j; v[j] = v[j] * ((ks1 && k >= 512) ? ks1[k - 512] : ks0[k]); } }
        if (shl) {
#pragma unroll
            for (int j = 0; j < 8; ++j) { b0 += v[j] * shl[k0 + j]; b1 += v[j] * shl[1024 + k0 + j]; } }
#pragma unroll
        for (int c = 0; c < 4; ++c) { LAS unsigned char* tp = tile + (4 * lane + c) * RS;
            if constexpr (OUT8) { u32x2 w; w.x = cvt4_fp8(v[0][c] * W8_SCALE, v[1][c] * W8_SCALE, v[2][c] * W8_SCALE, v[3][c] * W8_SCALE); w.y = cvt4_fp8(v[4][c] * W8_SCALE, v[5][c] * W8_SCALE, v[6][c] * W8_SCALE, v[7][c] * W8_SCALE);
                *(LAS u32x2*)(tp + 8 * wid) = w; }
            else { u32x2 w0, w1; w0.x = cvt_pk_bf16(v[0][c], v[1][c]); w0.y = cvt_pk_bf16(v[2][c], v[3][c]); w1.x = cvt_pk_bf16(v[4][c], v[5][c]); w1.y = cvt_pk_bf16(v[6][c], v[7][c]);
                *(LAS u32x2*)(tp + 16 * wid) = w0; *(LAS u32x2*)(tp + 16 * wid + 8) = w1; } }
        __syncthreads();
        { const int row = tid >> 1, hf = tid & 1;
          if constexpr (OUT8) { const LAS unsigned char* tp = tile + row * RS + hf * 32; unsigned char* dp = dst + (size_t)(n0 + row) * ldk + kb * 64 + hf * 32;
#pragma unroll
              for (int q = 0; q < 2; ++q) { const u32x2 lo = *(const LAS u32x2*)(tp + q * 16), hi2 = *(const LAS u32x2*)(tp + q * 16 + 8); gst16(dp + q * 16, (u32x4){lo.x, lo.y, hi2.x, hi2.y}); } }
          else { const LAS unsigned char* tp = tile + row * RS + hf * 64; bf16_t* dp = (bf16_t*)dst + (size_t)(n0 + row) * ldk + kb * 64 + hf * 32;
#pragma unroll
              for (int q = 0; q < 4; ++q) { const u32x2 lo = *(const LAS u32x2*)(tp + q * 16), hi2 = *(const LAS u32x2*)(tp + q * 16 + 8); gst16(dp + q * 8, (u32x4){lo.x, lo.y, hi2.x, hi2.y}); } } }
        __syncthreads();
#pragma unroll
        for (int j = 0; j < 8; ++j) v[j] = vn[j];
    }
    if (shl) {
#pragma unroll
        for (int c = 0; c < 4; ++c) { red[(0 * 8 + wid) * 256 + 4 * lane + c] = b0[c]; red[(1 * 8 + wid) * 256 + 4 * lane + c] = b1[c]; }
        __syncthreads();
        { const int b = tid >> 8, n = tid & 255; float a = 0.f;
#pragma unroll
          for (int j = 0; j < 8; ++j) a += red[(b * 8 + j) * 256 + n];
          atomicAdd((b ? bias1 : bias0) + n0 + n, a); }
        __syncthreads();
    }
}
constexpr int WI_EGU = 16 * 28 * 2, WI_ED = 16 * 4 * 7, WI_WGU = 2 * 20 * 2, WI_WD = 2 * 4 * 5, WI_WOUT = 4 * 4 * 2, N_WITEMS = WI_EGU + WI_ED + WI_WGU + WI_WD + WI_WOUT;
__device__ __forceinline__ void wide_item(const In& I, unsigned char* ws, int it, const LAS float* shl_all, ldsp lds) {
    int r = it;
    if (r < WI_EGU) { const int m = r / 56, rem = r % 56, st = rem >> 1, hf = rem & 1, i = m >> 3; const size_t so = (size_t)m * 1024 * DFE + st * 128;
        conv_wide<true>(I.w_ex_gate + so, I.w_ex_up + so, DFE, nullptr, nullptr, hf * 8, hf * 8 + 8, ws + WS_EGU + (size_t)m * (2 * DFE) * 1024, 1024, st * 256, shl_all + ((2 * i + 1) * 2 + 1) * 2048,
                        (float*)(ws + WS_BEGU) + ((size_t)m * 2 + 0) * (2 * DFE), (float*)(ws + WS_BEGU) + ((size_t)m * 2 + 1) * (2 * DFE), lds); return; }
    r -= WI_EGU;
    if (r < WI_ED) { const int m = r / 28, rem = r % 28, st = rem / 7, kp = rem % 7;
        conv_wide<true>(I.w_ex_down + (size_t)m * DFE * 1024 + st * 256, nullptr, 1024, nullptr, nullptr, kp * 8, kp * 8 + 8, ws + WS_ED + (size_t)m * 1024 * DFE, DFE, st * 256, nullptr, nullptr, nullptr, lds); return; }
    r -= WI_ED;
    if (r < WI_WGU) { const int i = r / 40, rem = r % 40, st = rem >> 1, hf = rem & 1; const size_t so = (size_t)i * 1024 * DFF + st * 128;
        conv_wide<false>(I.w_ff_gate + so, I.w_ff_up + so, DFF, nullptr, nullptr, hf * 8, hf * 8 + 8, ws + WS_WGU + (size_t)i * (2 * DFF) * 1024 * 2, 1024, st * 256, shl_all + ((2 * i) * 2 + 1) * 2048,
                         (float*)(ws + WS_BGU) + ((size_t)i * 2 + 0) * (2 * DFF), (float*)(ws + WS_BGU) + ((size_t)i * 2 + 1) * (2 * DFF), lds); return; }
    r -= WI_WGU;
    if (r < WI_WD) { const int i = r / 20, rem = r % 20, st = rem / 5, kp = rem % 5;
        conv_wide<false>(I.w_ff_down + (size_t)i * DFF * 1024 + st * 256, nullptr, 1024, nullptr, nullptr, kp * 8, kp * 8 + 8, ws + WS_WD + (size_t)i * 1024 * DFF * 2, DFF, st * 256, nullptr, nullptr, nullptr, lds); return; }
    r -= WI_WD;
    { const int l = r >> 3, rem = r & 7, st = rem >> 1, hf = rem & 1;
      conv_wide<false>(I.w_out + (size_t)l * 1024 * 1024 + st * 256, nullptr, 1024, I.g_grp_mla + l * 512, I.g_grp_sb + l * 512, hf * 8, hf * 8 + 8, ws + WS_WOUT + (size_t)l * 1024 * 1024 * 2, 1024, st * 256, nullptr, nullptr, nullptr, lds); }
}
__device__ __forceinline__ void sincos_red(float ang, float& sn, float& cs) {
    const double a = (double)ang; const double kq = __builtin_rint(a * 0.63661977236758134308); const int q = (int)kq & 3;
    const float r = (float)(a - kq * 1.57079632679489661923); const float r2 = r * r;
    const float s = r + r * r2 * (-1.6666667163e-1f + r2 * (8.3333337680e-3f + r2 * (-1.9841270114e-4f + r2 * 2.7557314297e-6f)));
    const float c = 1.0f + r2 * (-0.5f + r2 * (4.1666667908e-2f + r2 * (-1.3888889225e-3f + r2 * (2.4801587642e-5f + r2 * -2.7557314297e-7f))));
    sn = (q == 0) ? s : (q == 1) ? c : (q == 2) ? -s : -c; cs = (q == 0) ? c : (q == 1) ? -s : (q == 2) ? -c : s;
}
constexpr int NW_A0 = MT / 16, NW_GS = NL * 4 * 2 * 1024 / 64;
__device__ __forceinline__ void p0b_wave(const In& I, unsigned char* ws, int it, int lane) {
    const float* mod = (const float*)(ws + WS_MOD);
    if (it < NW_A0) {
        const int b = (it * 16) >> 13; const float* sc = mod + (size_t)b * 6144 + 1024;
        f32x4 gm[4];
#pragma unroll
        for (int j = 0; j < 4; ++j) { const int c0 = j * 256 + lane * 4; gm[j] = gld4(I.g_mix + c0) * (gld4(sc + c0) + 1.0f); }
#pragma unroll 1
        for (int q = 0; q < 4; ++q) { const int row0 = it * 16 + q * 4;
            f32x4 xv[4][4];
#pragma unroll
            for (int r = 0; r < 4; ++r)
#pragma unroll
                for (int j = 0; j < 4; ++j) xv[r][j] = gld4(I.x + (size_t)(row0 + r) * 1024 + j * 256 + lane * 4);
#pragma unroll
            for (int r = 0; r < 4; ++r) { const int row = row0 + r; bf16_t* ar = (bf16_t*)(ws + WS_AMIX) + (size_t)row * 1024; float ss = 0.f;
#pragma unroll
                for (int j = 0; j < 4; ++j) { const int c0 = j * 256 + lane * 4; ss += prob::dot4(xv[r][j]);
                    { u32x2 wx; wx.x = cvt_pk_bf16(xv[r][j][0], xv[r][j][1]); wx.y = cvt_pk_bf16(xv[r][j][2], xv[r][j][3]); gst8((bf16_t*)(ws + WS_X) + (size_t)row * 1024 + c0, wx); }
                    const f32x4 a = xv[r][j] * gm[j]; u32x2 w; w.x = cvt_pk_bf16(a[0], a[1]); w.y = cvt_pk_bf16(a[2], a[3]); gst8(ar + c0, w); }
                ss = wave_sum(ss);
                if (lane < 16) ((float*)(ws + WS_SSQX))[(size_t)row * 16 + lane] = lane == 0 ? ss : 0.f;
                if (lane < 16) { const float invf = exp2f(-(float)lane * (13.287712379549449f / 16.0f)); const float ang = (float)I.pos[row] * invf; float sn, cs; sincos_red(ang, sn, cs);
                    ((float*)(ws + WS_COS))[(size_t)row * 16 + lane] = cs; ((float*)(ws + WS_SIN))[(size_t)row * 16 + lane] = sn; } } }
    } else {
        const int idx = (it - NW_A0) * 64 + lane; const int k = idx & 1023, b = (idx >> 10) & 1, kind = (idx >> 11) & 3, l = idx >> 13; const float* mb = mod + ((size_t)l * 2 + b) * 6144;
        float v; if (kind == 0) v = I.g_mix[l * 1024 + k] * (1.0f + mb[1024 + k]); else if (kind == 1) v = mb[2048 + k]; else if (kind == 2) v = I.g_ffn[l * 1024 + k] * (1.0f + mb[4096 + k]); else v = mb[5120 + k];
        ((float*)(ws + WS_GS))[idx] = v;
    }
}
__device__ __forceinline__ const float* gs_ptr(const unsigned char* ws, int l, int kind) { return (const float*)(ws + WS_GS) + ((size_t)l * 4 + kind) * 2048; }

__device__ __forceinline__ void router_phase(const In& I, unsigned char* ws, int l, ldsp lds) {
    const int tid = launder_v(threadIdx.x), lane = tid & 63, wid = __builtin_amdgcn_readfirstlane(tid >> 6), i = l >> 1;
    LAS float* wr = (LAS float*)lds;
    LAS float* gs = (LAS float*)(lds + 32768);
    LAS float* br = (LAS float*)(lds + 40960);
    LAS int* lcnt = (LAS int*)(lds + 41216);
    LAS int* gbase = (LAS int*)(lds + 41280);
    LAS int* rec = (LAS int*)(lds + 41472);
    const float* gsf = gs_ptr(ws, l, 2); const float* mod = (const float*)(ws + WS_MOD);
    {
      f32x4 t[4], s0[4], s1[4]; const float* sh0 = mod + ((size_t)l * 2 + 0) * 6144 + 3072; const float* sh1 = sh0 + 6144;
#pragma unroll
      for (int j = 0; j < 4; ++j) t[j] = gld4(I.w_router + (size_t)i * 8192 + (size_t)(tid + 512 * j) * 4);
      const f32x4 g4 = gld4(gsf + tid * 4);
#pragma unroll
      for (int j = 0; j < 4; ++j) { s0[j] = gld4(sh0 + lane * 4 + 256 * j); s1[j] = gld4(sh1 + lane * 4 + 256 * j); }
      const float brb = I.b_router[i * 8 + wid];
#pragma unroll
      for (int j = 0; j < 4; ++j) *(LAS f32x4*)(wr + (tid + 512 * j) * 4) = t[j];
      *(LAS f32x4*)(gs + tid * 4) = g4;
      if (tid < 8) lcnt[tid] = 0;
      __syncthreads();
      float a0 = 0.f, a1 = 0.f;
#pragma unroll
      for (int j = 0; j < 4; ++j)
#pragma unroll
          for (int c = 0; c < 4; ++c) { const float w = wr[(lane * 4 + 256 * j + c) * 8 + wid]; a0 += s0[j][c] * w; a1 += s1[j][c] * w; }
      a0 = wave_sum(a0); a1 = wave_sum(a1);
      if (lane == 0) { br[wid] = a0 + brb; br[8 + wid] = a1 + brb; } }
    __syncthreads();
    const bf16_t* X = (const bf16_t*)(ws + WS_X); float* rtok = (float*)(ws + WS_RTOK); int* rowtok = (int*)(ws + WS_ROWTOK); float* roww = (float*)(ws + WS_ROWW); float* rowr = (float*)(ws + WS_ROWR);
    unsigned* cnt = (unsigned*)(ws + WS_CTL) + CW_CNT + i * 8 * 64;
    for (int base = blockIdx.x * 64; base < MT; base += gridDim.x * 64) {
        u32x2 xall[8][4];
#pragma unroll
        for (int j = 0; j < 8; ++j)
#pragma unroll
            for (int q = 0; q < 4; ++q) xall[j][q] = *(const GAS u32x2*)(X + (size_t)(base + wid * 8 + j) * 1024 + q * 256 + lane * 4);
#pragma unroll
        for (int j = 0; j < 8; ++j) {
            const int tk = base + wid * 8 + j, b = tk >> 13;
            float ss = 0.f, d[8];
#pragma unroll
            for (int e = 0; e < 8; ++e) d[e] = 0.f;
#pragma unroll
            for (int q = 0; q < 4; ++q) { const int c0 = q * 256 + lane * 4; const u32x2 xr = xall[j][q]; const f32x4 xv = (f32x4){bf_lo(xr.x), bf_hi(xr.x), bf_lo(xr.y), bf_hi(xr.y)}; ss += prob::dot4(xv);
#pragma unroll
                for (int jj = 0; jj < 4; ++jj) { const float a = xv[jj] * gs[b * 1024 + c0 + jj]; const f32x4 w0 = *(const LAS f32x4*)(wr + (c0 + jj) * 8), w1 = *(const LAS f32x4*)(wr + (c0 + jj) * 8 + 4);
                    d[0] += a * w0[0]; d[1] += a * w0[1]; d[2] += a * w0[2]; d[3] += a * w0[3]; d[4] += a * w1[0]; d[5] += a * w1[1]; d[6] += a * w1[2]; d[7] += a * w1[3]; } }
            ss = wave_sum(ss); const float r = rsq_(ss * (1.0f / 1024.0f) + EPS);
            float lg[8];
#pragma unroll
            for (int e = 0; e < 8; ++e) lg[e] = wave_sum(d[e]) * r + br[b * 8 + e];
            int e1 = 0; float v1 = lg[0];
#pragma unroll
            for (int e = 1; e < 8; ++e) if (lg[e] > v1) { v1 = lg[e]; e1 = e; }
            int e2 = -1; float v2 = -INFINITY;
#pragma unroll
            for (int e = 0; e < 8; ++e) if (e != e1 && lg[e] > v2) { v2 = lg[e]; e2 = e; }
            const float w2 = 1.0f / (1.0f + __expf(v1 - v2)), w1 = 1.0f - w2;
            if (lane == 0) { const int li1 = __hip_atomic_fetch_add(lcnt + e1, 1, __ATOMIC_RELAXED, __HIP_MEMORY_SCOPE_WORKGROUP), li2 = __hip_atomic_fetch_add(lcnt + e2, 1, __ATOMIC_RELAXED, __HIP_MEMORY_SCOPE_WORKGROUP);
                LAS int* rc = rec + (wid * 8 + j) * 8; rc[0] = e1; rc[1] = e2; rc[2] = li1; rc[3] = li2; rc[4] = __float_as_int(w1); rc[5] = __float_as_int(w2); rc[6] = __float_as_int(r); rtok[tk] = r; }
        }
        __syncthreads();
        if (tid < 8) { gbase[tid] = (int)__hip_atomic_fetch_add(cnt + tid * 64, (unsigned)lcnt[tid], __ATOMIC_RELAXED, __HIP_MEMORY_SCOPE_AGENT); }
        __syncthreads();
        if (tid < 128) { const int t = tid >> 1, sl = tid & 1; const LAS int* rc = rec + t * 8; const int e = rc[sl], p = gbase[e] + rc[2 + sl];
            rowtok[(size_t)e * MT + p] = (base + t) * 2 + sl; roww[(size_t)e * MT + p] = __int_as_float(rc[4 + sl]); rowr[(size_t)e * MT + p] = __int_as_float(rc[6]); }
        __syncthreads();
        if (tid < 8) lcnt[tid] = 0;
        __syncthreads();
    }
}
__device__ __forceinline__ void combine_phase(const In& I, unsigned char* ws, float* out, int l) {
    const int tid = launder_v(threadIdx.x), lane = tid & 63, wid = tid >> 6; const bool lastl = (l == NL - 1);
    bf16_t* X = (bf16_t*)(ws + WS_X); const bf16_t* Y = (const bf16_t*)(ws + WS_Y); const float* gate = gs_ptr(ws, l, 3); const float* gsn = gs_ptr(ws, lastl ? l : l + 1, 0);
    for (int row8 = (blockIdx.x * 8 + wid) * 8; row8 < MT; row8 += gridDim.x * 64) {
      f32x4 gq[4], nq[4];
#pragma unroll
      for (int q = 0; q < 4; ++q) { const int c0 = q * 256 + lane * 4, bq = row8 >> 13; gq[q] = gld4(gate + bq * 1024 + c0); nq[q] = lastl ? gld4(I.g_final + c0) : gld4(gsn + bq * 1024 + c0); }
#pragma unroll
      for (int hb = 0; hb < 2; ++hb) { const int row0 = row8 + hb * 4;
        u32x2 xv[4][4]; u32x2 y0[4][4], y1[4][4];
#pragma unroll
        for (int r = 0; r < 4; ++r)
#pragma unroll
            for (int q = 0; q < 4; ++q) { const int c0 = q * 256 + lane * 4; const size_t row = (size_t)(row0 + r);
                xv[r][q] = *(const GAS u32x2*)(X + row * 1024 + c0); y0[r][q] = *(const GAS u32x2*)(Y + (2 * row) * 1024 + c0); y1[r][q] = *(const GAS u32x2*)(Y + (2 * row + 1) * 1024 + c0); }
#pragma unroll
        for (int r = 0; r < 4; ++r) { const int row = row0 + r; f32x4 xn[4]; float ss = 0.f;
#pragma unroll
            for (int q = 0; q < 4; ++q) { const f32x4 g = gq[q]; const u32x2 a0 = y0[r][q], a1 = y1[r][q];
                const f32x4 ys = (f32x4){bf_lo(a0.x) + bf_lo(a1.x), bf_hi(a0.x) + bf_hi(a1.x), bf_lo(a0.y) + bf_lo(a1.y), bf_hi(a0.y) + bf_hi(a1.y)};
                const u32x2 xr = xv[r][q]; xn[q] = (f32x4){bf_lo(xr.x), bf_hi(xr.x), bf_lo(xr.y), bf_hi(xr.y)} + g * ys; ss += prob::dot4(xn[q]); }
            ss = wave_sum(ss);
            if (lastl) { const float rr = rsq_(ss * (1.0f / 1024.0f) + EPS);
#pragma unroll
                for (int q = 0; q < 4; ++q) { const int c0 = q * 256 + lane * 4; gst4(out + (size_t)row * 1024 + c0, xn[q] * rr * nq[q]); }
            } else {
#pragma unroll
                for (int q = 0; q < 4; ++q) { const int c0 = q * 256 + lane * 4; { u32x2 wx; wx.x = cvt_pk_bf16(xn[q][0], xn[q][1]); wx.y = cvt_pk_bf16(xn[q][2], xn[q][3]); gst8(X + (size_t)row * 1024 + c0, wx); } const f32x4 a = xn[q] * nq[q];
                    u32x2 w; w.x = cvt_pk_bf16(a[0], a[1]); w.y = cvt_pk_bf16(a[2], a[3]); gst8((bf16_t*)(ws + WS_AMIX) + (size_t)row * 1024 + c0, w); }
                if (lane < 16) ((float*)(ws + WS_SSQX))[(size_t)row * 16 + lane] = lane == 0 ? ss : 0.f;
            } } }
    }
}

constexpr int N_PHASE = 2 + 8 * NL;
__global__ void __launch_bounds__(512, 2) fwd_kernel(Args args) {
    extern __shared__ __attribute__((aligned(16))) unsigned char lds_raw[];
    const ldsp lds = (ldsp)lds_raw; const ldsp tab = lds + TAB_OFF;
    volatile LAS unsigned* MISC = (volatile LAS unsigned*)(lds + MISC_OFF);
    const int tid = threadIdx.x; const int G = gridDim.x, bx = blockIdx.x; const int vcu = (G % 8 == 0) ? (bx % 8) * (G / 8) + bx / 8 : bx;
    unsigned char* const ws0 = args.ws;
#define LOAD_IN(I) In I; I.x = (const float*)args.in[0]; I.c = (const float*)args.in[1]; I.pos = (const int*)args.in[2]; I.w_ada = (const float*)args.in[3]; I.b_ada = (const float*)args.in[4]; I.g_mix = (const float*)args.in[5]; \
    I.g_ffn = (const float*)args.in[6]; I.w_in = (const float*)args.in[7]; I.g_q_lat = (const float*)args.in[8]; I.w_uq = (const float*)args.in[9]; I.g_kv_lat = (const float*)args.in[10]; I.w_ukv = (const float*)args.in[11]; \
    I.g_grp_mla = (const float*)args.in[12]; I.g_grp_sb = (const float*)args.in[13]; I.w_out = (const float*)args.in[14]; I.w_ff_gate = (const float*)args.in[15]; I.w_ff_up = (const float*)args.in[16]; I.w_ff_down = (const float*)args.in[17]; \
    I.w_router = (const float*)args.in[18]; I.b_router = (const float*)args.in[19]; I.w_ex_gate = (const float*)args.in[20]; I.w_ex_up = (const float*)args.in[21]; I.w_ex_down = (const float*)args.in[22]; I.g_final = (const float*)args.in[23]
#define WSP(name) unsigned char* name = ws0; asm volatile("" : "+s"(name))
    for (int u = tid; u < 256; u += 512) MISC[u] = 0u;
    __syncthreads();
    const XcdBarrier bar = xcd_barrier_post((unsigned*)(ws0 + WS_CTL) + CW_BAR, MISC + 8);
    const int lo = args.lo, hi = args.hi;
#ifndef PHMASK
#define PHMASK 0xFFFFFFFFu
#endif
#define PHON(j) ((PHMASK >> (j)) & 1u)
#ifndef REP_PH
#define REP_PH -1
#define REP_N 1
#endif
#ifndef REP_DRY
#define REP_DRY 0
#endif
#define REPS(j) for (int rep_ = 0; rep_ < ((REP_PH) == (j) ? (REP_N) : 1); ++rep_)
#define IN(k) (lo <= (k) && (k) < hi)
#define SEAM(k) do { if (lo < (k) && (k) < hi) xcd_barrier(bar); } while (0)

    REPS(0) {
    if (rep_ > 0) xcd_barrier(bar);
    if (PHON(0) && IN(0)) { LOAD_IN(I); p0a_mod(I, (float*)(ws0 + WS_MOD), lds);
        { constexpr int NZ = (int)((WS_SSQX - WS_BGU) / 16); const int zb = G > NL * 48 ? G - NL * 48 : G, z0 = G > NL * 48 ? bx - NL * 48 : bx;
          if (z0 >= 0) for (int i = z0 * 512 + tid; i < NZ; i += zb * 512) gst4((float*)(ws0 + WS_BGU) + (size_t)i * 4, f32x4{0.f, 0.f, 0.f, 0.f}); } }
    SEAM(1);
    if (PHON(1) && IN(1)) { LOAD_IN(I);
        {
          LAS float* shl = (LAS float*)(lds + 8 * 8448); const float* mod = (const float*)(ws0 + WS_MOD);
          { f32x4 t[8];
#pragma unroll
            for (int j = 0; j < 8; ++j) { const int i = (tid + 512 * j) * 4; const int k = i & 1023, b = (i >> 10) & 1, kind = (i >> 11) & 1, l = i >> 12; t[j] = gld4(mod + ((size_t)l * 2 + b) * 6144 + kind * 3072 + k); }
#pragma unroll
            for (int j = 0; j < 8; ++j) *(LAS f32x4*)(shl + (tid + 512 * j) * 4) = t[j]; }
          __syncthreads();
          const int lane = tid & 63, wid = __builtin_amdgcn_readfirstlane(tid >> 6); LAS float* scr = (LAS float*)(lds + wid * 8448);
          unsigned* qh = (unsigned*)(ws0 + WS_CTL) + CW_QUEUE; volatile LAS int* qslot = (volatile LAS int*)(lds + MISC_OFF + 512);
          for (;;) {
              if (tid == 0) *qslot = (int)__hip_atomic_fetch_add(qh, 1u, __ATOMIC_RELAXED, __HIP_MEMORY_SCOPE_AGENT);
              __syncthreads(); const int it = *qslot; __syncthreads();
              if (it >= N_WITEMS) break; wide_item(I, ws0, it, shl, lds); }
          for (;;) { int it = 0; if (lane == 0) it = (int)__hip_atomic_fetch_add(qh + 64, 1u, __ATOMIC_RELAXED, __HIP_MEMORY_SCOPE_AGENT); it = __builtin_amdgcn_readfirstlane(it);
              if (it >= CI_WIN + CI_WUQ + CI_WUKV + NW_A0 + NW_GS) break;
              if (it >= CI_WIN + CI_WUQ + CI_WUKV) { p0b_wave(I, ws0, it - (CI_WIN + CI_WUQ + CI_WUKV), lane); continue; }
              int ci = it < CI_WIN ? CI_SKIP + it : CI_SKIP + CI_WOUT + it; conv_item(I, ws0, ci, shl, scr, lane); }
          __syncthreads(); } }
    }

#pragma nounroll
    for (int l = 0; l < NL; ++l) {
        const int pb = 2 + 8 * l;
        SEAM(pb + 0);
        REPS(2) if (PHON(2) && IN(pb + 0)) { WSP(ws); prob::PIn P; P.A = (const char*)(ws + WS_AMIX); P.lda = 1024; P.K = 1024; P.Bt = (const char*)((bf16_t*)(ws + WS_WIN) + (size_t)l * INP * 1024); P.ord.init(64, 8, G, launder_s(bx));
            P.ws = ws; P.l = l;
            P.dry = rep_ > 0 ? REP_DRY : 0; pg8::gemm_phase<prob::PIn, true>(lds, tab, P); }
        SEAM(pb + 1);
        if (PHON(3) && IN(pb + 1)) {
            REPS(12) if (PHON(12)) { WSP(ws); prob::PQ P; P.A = (const char*)(ws + WS_PROJ); P.lda = INP; P.K = 256; P.Bt = (const char*)((bf16_t*)(ws + WS_WUQ) + (size_t)l * QW * 256); P.ord.init(64, 3, G, launder_s(bx));
              P.ws = ws;
              P.dry = rep_ > 0 ? REP_DRY : 0; pg8::gemm_phase<prob::PQ, true>(lds, tab, P); }
            REPS(12) if (PHON(13)) { WSP(ws); prob::PKV P; P.A = (const char*)(ws + WS_PROJ + 512); P.lda = INP; P.K = 256; P.Bt = (const char*)((bf16_t*)(ws + WS_WUKV) + (size_t)l * KVW * 256); P.ord.init(64, 4, G, launder_s(bx));
              P.ws = ws;
              P.dry = rep_ > 0 ? REP_DRY : 0; pg8::gemm_phase<prob::PKV, true>(lds, tab, P); }
            REPS(14) if (PHON(14)) { WSP(ws); int bh, qb; const int vc = launder_s(vcu); for (int i = 0; att::att_next(i, vc, G, bh, qb); ++i) att::sb_unit(bh >> 3, bh & 7, qb, (const bf16_t*)(ws + WS_PROJ), (bf16_t*)(ws + WS_OCAT), (float*)(ws + WS_SSQO), lds, MISC + 16); }
        }
        SEAM(pb + 2);
        REPS(4) if (PHON(4) && IN(pb + 2)) { WSP(ws); int bh, qb; const int vc = launder_s(vcu); for (int i = 0; att::att_next(i, vc, G, bh, qb); ++i)
            att::mla_unit(bh >> 3, bh & 7, qb, (const bf16_t*)(ws + WS_QMLA), (const bf16_t*)(ws + WS_KV), (const bf16_t*)(ws + WS_PROJ), (bf16_t*)(ws + WS_OCAT), (float*)(ws + WS_SSQO), lds); }
        SEAM(pb + 3);
        REPS(5) if (PHON(5) && IN(pb + 3)) { WSP(ws); prob::POut P; P.A = (const char*)(ws + WS_OCAT); P.lda = 1024; P.K = 1024; P.Bt = (const char*)((bf16_t*)(ws + WS_WOUT) + (size_t)l * 1024 * 1024); P.ord.init(64, 4, G, launder_s(bx));
            P.ws = ws; P.l = l; P.xin0 = (const float*)args.in[0];
            P.dry = rep_ > 0 ? REP_DRY : 0; pg8::gemm_phase<prob::POut, true>(lds, tab, P); }
        if ((l & 1) == 0) {
            const int i = l >> 1;
            SEAM(pb + 4);
            REPS(6) if (PHON(6) && IN(pb + 4)) { WSP(ws); prob::PGU P; P.A = (const char*)(ws + WS_AFFN); P.lda = 1024; P.K = 1024; P.Bt = (const char*)((bf16_t*)(ws + WS_WGU) + (size_t)i * (2 * DFF) * 1024); P.ord.init(64, 20, G, launder_s(bx));
                P.ws = ws; P.i = i;
                P.dry = rep_ > 0 ? REP_DRY : 0; pg8::gemm_phase<prob::PGU, true>(lds, tab, P); }
            SEAM(pb + 5);
            REPS(7) if (PHON(7) && IN(pb + 5)) { WSP(ws); prob::PDown P; P.A = (const char*)(ws + WS_ACT); P.lda = DFF; P.K = DFF; P.Bt = (const char*)((bf16_t*)(ws + WS_WD) + (size_t)i * 1024 * DFF); P.ord.init(64, 4, G, launder_s(bx));
                P.ws = ws; P.l = l;
                P.dry = rep_ > 0 ? REP_DRY : 0; pg8::gemm_phase<prob::PDown, true>(lds, tab, P); }
        } else {
            const int i = l >> 1;
            SEAM(pb + 4);
            if (PHON(8) && IN(pb + 4)) { LOAD_IN(I); WSP(ws); router_phase(I, ws, l, lds); }
            SEAM(pb + 5);
            prob::MoeTab mt; mt.p = (LAS int*)(lds + MISC_OFF + 128);
            if (IN(pb + 5) || IN(pb + 6)) {
                __syncthreads();
                { const int t8 = launder_v(threadIdx.x); const unsigned* cnt = (const unsigned*)(ws0 + WS_CTL) + CW_CNT + i * 8 * 64;
                  if (t8 < 8) mt.p[32 + t8] = (int)__hip_atomic_load(cnt + t8 * 64, __ATOMIC_RELAXED, __HIP_MEMORY_SCOPE_AGENT);
                  __syncthreads();
                  if (t8 == 0) { int tp = 0, rb = 0;
                    for (int e = 0; e < 8; ++e) { const int c = mt.p[32 + e]; mt.p[e] = tp; mt.p[16 + e] = rb; tp += (c + 255) >> 8; rb += c; }
                    mt.p[8] = tp; } }
                __syncthreads();
            }
            REPS(9) if (PHON(9) && IN(pb + 5)) { WSP(ws); prob::PEGU P; P.A = (const char*)(ws + WS_AFFN); P.lda = 512; P.K = 512; P.Bt = (const char*)(ws + WS_EGU) + (size_t)i * NE * (2 * DFE) * 1024; P.ord.init(mt.ntiles(), 28, G, launder_s(bx));
                P.mt = mt; P.ws = ws; P.i = i;
                P.dry = rep_ > 0 ? REP_DRY : 0; pg8::gemm_phase<prob::PEGU, true>(lds, tab, P); }
            SEAM(pb + 6);
            REPS(10) if (PHON(10) && IN(pb + 6)) { WSP(ws); prob::PED P; P.A = (const char*)(ws + WS_ACT); P.lda = DFE / 2; P.K = DFE / 2; P.Bt = (const char*)(ws + WS_ED) + (size_t)i * NE * 1024 * DFE; P.ord.init(mt.ntiles(), 4, G, launder_s(bx));
                P.mt = mt; P.ws = ws;
                P.dry = rep_ > 0 ? REP_DRY : 0; pg8::gemm_phase<prob::PED, true>(lds, tab, P); }
            SEAM(pb + 7);
            if (PHON(11) && IN(pb + 7)) { LOAD_IN(I); WSP(ws); combine_phase(I, ws, args.out, l); }
        }
    }
#undef IN
#undef SEAM
}

#ifndef MK_ONE_LAUNCH
#define MK_ONE_LAUNCH 1
#endif
extern "C" void kernel_launch(void* const* d_in, const int* in_sizes, int n_in, void* d_out, int out_size, void* d_ws, size_t ws_size, hipStream_t stream) {
    static int grid = 0;
    if (grid == 0) {
        if (n_in != 24 || out_size != MT * DM || ws_size < WS_END) { fprintf(stderr, "kernel_launch: unexpected problem (n_in %d, out %d, ws %zu < %zu)\n", n_in, out_size, ws_size, (size_t)WS_END); grid = -1; return; }
        int dev = 0, cus = 0, per_cu = 0;
        if (hipGetDevice(&dev) != hipSuccess || hipDeviceGetAttribute(&cus, hipDeviceAttributeMultiprocessorCount, dev) != hipSuccess) { grid = -1; return; }
        if (hipFuncSetAttribute((const void*)fwd_kernel, hipFuncAttributeMaxDynamicSharedMemorySize, LDS_BYTES) != hipSuccess) { fprintf(stderr, "kernel_launch: hipFuncSetAttribute failed\n"); grid = -1; return; }
        if (hipOccupancyMaxActiveBlocksPerMultiprocessor(&per_cu, (const void*)fwd_kernel, 512, LDS_BYTES) != hipSuccess || per_cu < 1) { fprintf(stderr, "kernel_launch: occupancy query says %d\n", per_cu); grid = -1; (void)hipGetLastError(); return; }
        grid = cus;
    }
    if (grid < 0) return;
    (void)hipMemsetAsync((char*)d_ws + WS_CTL, 0, CTL_BYTES, stream);
    Args a{};
    for (int i = 0; i < 24; ++i) a.in[i] = d_in[i];
    a.out = (float*)d_out; a.ws = (unsigned char*)d_ws;
#if MK_ONE_LAUNCH
    a.lo = 0; a.hi = N_PHASE;
    hipLaunchKernelGGL(fwd_kernel, dim3(grid), dim3(512), LDS_BYTES, stream, a);
#else
    for (int p = 0; p < N_PHASE; ++p) {
        const int l = (p - 2) >> 3, j = (p - 2) & 7;
        if (p >= 2 && (l & 1) == 0 && j >= 6) continue;
        a.lo = p; a.hi = p + 1;
        hipLaunchKernelGGL(fwd_kernel, dim3(grid), dim3(512), LDS_BYTES, stream, a);
    }
#endif
}
```

```cpp
#include <hip/hip_runtime.h>
#include <cstdio>
#include <cstdint>

#define LAS __attribute__((address_space(3)))
#define GAS __attribute__((address_space(1)))
typedef unsigned short bf16_t;
typedef short bf16x8 __attribute__((ext_vector_type(8)));
typedef short s16x4 __attribute__((ext_vector_type(4)));
typedef float f32x2 __attribute__((ext_vector_type(2)));
typedef float f32x4 __attribute__((ext_vector_type(4)));
typedef float f32x16 __attribute__((ext_vector_type(16)));
typedef unsigned u32x2 __attribute__((ext_vector_type(2)));
typedef unsigned u32x4 __attribute__((ext_vector_type(4)));
typedef LAS unsigned char* ldsp;

constexpr int NB = 2, SEQ = 8192, MT = NB * SEQ, DM = 1024, NL = 4;
constexpr int INC = 1952, INP = 2048;
constexpr int QW = 768, KVW = 1024;
constexpr int DFF = 2560, DFE = 3584, NE = 8;
constexpr float EPS = 1e-6f;
constexpr float LOG2E = 1.4426950408889634f;
constexpr float C2Q = 0.10206207261596575f * LOG2E;
constexpr float C2S = 0.125f * LOG2E;
constexpr float SB_DONE = -150.0f;

constexpr size_t al256(size_t x) { return (x + 255) & ~(size_t)255; }
constexpr size_t WS_CTL = 0, CTL_BYTES = 65536;
constexpr size_t WS_MOD = WS_CTL + CTL_BYTES;
constexpr size_t WS_GS = WS_MOD + (size_t)NL * 2 * 6144 * 4;
constexpr size_t WS_COS = WS_GS + (size_t)NL * 4 * 2 * 1024 * 4;
constexpr size_t WS_SIN = WS_COS + (size_t)MT * 16 * 4;
constexpr size_t WS_BIN = WS_SIN + (size_t)MT * 16 * 4;
constexpr size_t WS_BGU = WS_BIN + (size_t)NL * 2 * INP * 4;
constexpr size_t WS_BEGU = WS_BGU + (size_t)2 * 2 * 2 * DFF * 4;
constexpr size_t WS_SSQX = WS_BEGU + (size_t)2 * NE * 2 * 2 * DFE * 4;
constexpr size_t WS_SSQL = WS_SSQX + (size_t)MT * 16 * 4;
constexpr size_t WS_SSQO = WS_SSQL + (size_t)MT * 8 * 4;
constexpr size_t WS_RTOK = WS_SSQO + (size_t)MT * 16 * 4;
constexpr size_t WS_ROWTOK = WS_RTOK + (size_t)MT * 4;
constexpr size_t WS_ROWW = WS_ROWTOK + (size_t)NE * MT * 4;
constexpr size_t WS_ROWR = WS_ROWW + (size_t)NE * MT * 4;
constexpr size_t WS_WIN = al256(WS_ROWR + (size_t)NE * MT * 4);
constexpr size_t WS_WUQ = WS_WIN + (size_t)NL * INP * 1024 * 2;
constexpr size_t WS_WUKV = WS_WUQ + (size_t)NL * QW * 256 * 2;
constexpr size_t WS_WOUT = WS_WUKV + (size_t)NL * KVW * 256 * 2;
constexpr size_t WS_WGU = WS_WOUT + (size_t)NL * 1024 * 1024 * 2;
constexpr size_t WS_WD = WS_WGU + (size_t)2 * 2 * DFF * 1024 * 2;
constexpr size_t WS_EGU = WS_WD + (size_t)2 * 1024 * DFF * 2;
constexpr size_t WS_ED = WS_EGU + (size_t)2 * NE * 2 * DFE * 1024 * 2;
constexpr size_t WS_X = WS_ED + (size_t)2 * NE * 1024 * DFE * 2;
constexpr size_t WS_AMIX = WS_X + (size_t)MT * 1024 * 4;
constexpr size_t WS_AFFN = WS_AMIX + (size_t)MT * 1024 * 2;
constexpr size_t WS_Y = WS_AFFN + (size_t)MT * 1024 * 2;
constexpr size_t WS_OVL = WS_Y + (size_t)2 * MT * 1024 * 2;
constexpr size_t WS_PROJ = WS_OVL;
constexpr size_t WS_QMLA = WS_PROJ + (size_t)MT * INP * 2;
constexpr size_t WS_KV = WS_QMLA + (size_t)MT * QW * 2;
constexpr size_t WS_OCAT = WS_KV + (size_t)MT * KVW * 2;
constexpr size_t WS_ACT = WS_OVL;
constexpr size_t WS_END = WS_OVL + (size_t)(2 * MT + 256) * DFE * 2;
static_assert(WS_OCAT + (size_t)MT * 1024 * 2 <= WS_END, "overlay");
static_assert(WS_END < (size_t)930 * 1024 * 1024, "workspace budget");
constexpr int CW_BAR = 1024;
constexpr int CW_QUEUE = 12288;
constexpr int CW_CNT = 8192;

constexpr int RING_BYTES = 131072;
constexpr int TAB_OFF = RING_BYTES;
constexpr int MISC_OFF = TAB_OFF + 10240;
constexpr int LDS_BYTES = 147456;

__device__ __forceinline__ unsigned cvt_pk_bf16(float lo, float hi) { unsigned r; asm volatile("v_cvt_pk_bf16_f32 %0, %1, %2" : "=v"(r) : "v"(lo), "v"(hi)); return r; }
__device__ __forceinline__ float clamp448(float x) { return __builtin_fminf(__builtin_fmaxf(x, -448.0f), 448.0f); }
__device__ __forceinline__ unsigned cvt4_fp8(float a, float b, float c, float d) {
    int p = __builtin_amdgcn_cvt_pk_fp8_f32(clamp448(a), clamp448(b), 0, false); p = __builtin_amdgcn_cvt_pk_fp8_f32(clamp448(c), clamp448(d), p, true); return (unsigned)p; }
constexpr float W8_SCALE = 64.0f, H8_SCALE = 16.0f;
__device__ __forceinline__ float bf_lo(unsigned u) { return __uint_as_float(u << 16); }
__device__ __forceinline__ float bf_hi(unsigned u) { return __uint_as_float(u & 0xffff0000u); }
__device__ __forceinline__ f32x4 gld4(const float* p) { return *(const GAS f32x4*)p; }
__device__ __forceinline__ f32x4 gld4_nt(const float* p) { return __builtin_nontemporal_load((const GAS f32x4*)p); }
__device__ __forceinline__ void gst4(float* p, f32x4 v) { *(GAS f32x4*)p = v; }
__device__ __forceinline__ void gst16(void* p, u32x4 v) { *(GAS u32x4*)p = v; }
__device__ __forceinline__ void gst8(void* p, u32x2 v) { *(GAS u32x2*)p = v; }
__device__ __forceinline__ float wave_sum(float v) {
#pragma unroll
    for (int o = 1; o < 64; o <<= 1) v += __shfl_xor(v, o);
    return v;
}
__device__ __forceinline__ int launder_s(int v) { asm volatile("" : "+s"(v)); return v; }
__device__ __forceinline__ int launder_v(int v) { asm volatile("" : "+v"(v)); return v; }
__device__ __forceinline__ float ex2(float x) { return __builtin_amdgcn_exp2f(x); }
__device__ __forceinline__ float lg2(float x) { return __builtin_amdgcn_logf(x); }
__device__ __forceinline__ float rcpf_(float x) { return __builtin_amdgcn_rcpf(x); }
__device__ __forceinline__ float rsq_(float x) { return 1.0f / sqrtf(x); }
__device__ __forceinline__ float silu_(float g) { return g * rcpf_(1.0f + ex2(-g * LOG2E)); }
__device__ __forceinline__ float sum16(const float* p) {
    const f32x4 a = gld4(p), b = gld4(p + 4), c = gld4(p + 8), d = gld4(p + 12);
    return ((a[0] + a[1]) + (a[2] + a[3])) + ((b[0] + b[1]) + (b[2] + b[3])) + ((c[0] + c[1]) + (c[2] + c[3])) + ((d[0] + d[1]) + (d[2] + d[3]));
}
__host__ __device__ __forceinline__ int ropedim(int p) { const int g = p >> 3, j = p & 7; return j < 4 ? 4 * g + j : 16 + 4 * g + (j - 4); }

#define XB_TMO      128
#define XB_XCNT(j)  (256  + 64 * (j))
#define XB_XSUB(j)  (1280 + 64 * (j))
#define XB_XGEN(j)  (2304 + 64 * (j))
#define XB_TOP      3328
#define XB_TOPGEN   3392
#define XCD_BAR_WORDS 3456
#define XB_SPIN_CAP (1u << 18)
__device__ __forceinline__ unsigned xb_ld(unsigned* p)              { return __hip_atomic_load(p, __ATOMIC_RELAXED, __HIP_MEMORY_SCOPE_AGENT); }
__device__ __forceinline__ unsigned xb_add(unsigned* p, unsigned v) { return __hip_atomic_fetch_add(p, v, __ATOMIC_RELAXED, __HIP_MEMORY_SCOPE_AGENT); }
__device__ __forceinline__ unsigned xb_xcc_id() { return (unsigned)__builtin_amdgcn_s_getreg((3 << 11) | 20) & 0xFu; }
#define XB_SPIN(cond, bar) do { unsigned _sp = 0; while (cond) { __builtin_amdgcn_s_sleep(1); \
    if ((++_sp & 255u) == 0u) { if (xb_ld(&(bar)[XB_TMO])) break; if (_sp > XB_SPIN_CAP) { atomicAdd(&(bar)[XB_TMO], 1u); break; } } } } while (0)
struct XcdBarrier { unsigned* bar; unsigned x; volatile LAS unsigned* st; };
__device__ __forceinline__ XcdBarrier xcd_barrier_post(unsigned* bar, volatile LAS unsigned* st) {
    XcdBarrier b; b.bar = bar; b.x = xb_xcc_id(); b.st = st;
    if (threadIdx.x == 0) (void)xb_add(&bar[XB_XCNT(b.x)], 1u);
    return b;
}
__device__ __forceinline__ void xcd_barrier_complete(unsigned* bar, unsigned x, unsigned& nloc, unsigned& nx) {
    const unsigned G = gridDim.x * gridDim.y * gridDim.z;
    unsigned sum, cnt, mine, sp = 0u;
    for (;;) {
        sum = 0u; cnt = 0u; mine = 0u;
#pragma unroll
        for (unsigned j = 0; j < 16; ++j) { const unsigned c = xb_ld(&bar[XB_XCNT(j)]); sum += c; cnt += (c > 0u) ? 1u : 0u; mine = (j == x) ? c : mine; }
        if (sum == G) break;
        __builtin_amdgcn_s_sleep(1);
        if ((++sp & 255u) == 0u) { if (xb_ld(&bar[XB_TMO])) break; if (sp > XB_SPIN_CAP) { atomicAdd(&bar[XB_TMO], 1u); break; } }
    }
    nloc = mine > 0u ? mine : 1u; nx = cnt > 0u ? cnt : 1u;
}
__device__ __forceinline__ void xcd_barrier(const XcdBarrier& b) {
    asm volatile("s_waitcnt vmcnt(0)" ::: "memory");
    __syncthreads();
    if (threadIdx.x == 0) {
        unsigned* bar = b.bar;
        __builtin_amdgcn_s_waitcnt(0);
        unsigned nloc = b.st[0], nx = b.st[1];
        if (nloc == 0u) { xcd_barrier_complete(bar, b.x, nloc, nx); b.st[0] = nloc; b.st[1] = nx; }
        const unsigned old = xb_add(&bar[XB_XSUB(b.x)], 1u);
        const unsigned gen = old / nloc;
        if (old + 1u == (gen + 1u) * nloc) {
            __builtin_amdgcn_fence(__ATOMIC_RELEASE, "agent");
            asm volatile("s_waitcnt vmcnt(0)" ::: "memory");
            const unsigned og = xb_add(&bar[XB_TOP], 1u);
            const unsigned tg = og / nx;
            if (og + 1u == (tg + 1u) * nx) xb_add(&bar[XB_TOPGEN], 1u);
            else XB_SPIN(xb_ld(&bar[XB_TOPGEN]) == tg, bar);
            __builtin_amdgcn_fence(__ATOMIC_ACQUIRE, "agent");
            xb_add(&bar[XB_XGEN(b.x)], 1u);
            asm volatile("s_waitcnt vmcnt(0)" ::: "memory");
        } else {
            XB_SPIN(xb_ld(&bar[XB_XGEN(b.x)]) == gen, bar);
            __builtin_amdgcn_fence(__ATOMIC_ACQUIRE, "agent");
            asm volatile("s_waitcnt vmcnt(0)" ::: "memory");
        }
    }
    __syncthreads();
}

namespace pg8 {
constexpr int BM = 256, BK = 64, HALF = 128, HTB = HALF * BK * 2, STAGE_BYTES = 8 * HTB, NXCD = 8, WGM = 8;
__host__ __device__ __forceinline__ int lds_byte(int r, int c) { const int st = (r >> 4) * 2 + (c >> 5), rr = r & 15, cc = c & 31, ob = rr * 64 + cc * 2; return st * 1024 + (ob ^ (((ob >> 9) & 1) << 5)); }
__host__ __device__ __forceinline__ void stage_rc(int b, int& R, int& C) { const int st = b / 1024, sb = b % 1024, swz = sb ^ (((sb >> 9) & 1) << 5); R = (st >> 1) * 16 + swz / 64; C = (st & 1) * 32 + (swz % 64) / 2; }
__host__ __device__ __forceinline__ int perm32(int rho) { const int n = rho >> 4, i = rho & 15; return 8 * (i >> 2) + 4 * n + (i & 3); }
struct Unit { int pm, pn, e, lt; };
struct Order {
    int nM, nN, nwg, G, c;
    __device__ __forceinline__ void init(int nM_, int nN_, int G_, int c_) { nM = nM_; nN = nN_; nwg = nM * nN; G = G_; c = c_; }
    __device__ __forceinline__ bool next(int i, Unit& u) const {
        const long L = (long)i * G + c; if (L >= nwg) return false;
        int wgid = (int)L; { const int q = nwg / NXCD, r = nwg % NXCD, xcd = wgid % NXCD, off = wgid / NXCD; wgid = (xcd < r ? xcd * (q + 1) : r * (q + 1) + (xcd - r) * q) + off; }
        const int nig = WGM * nN, gid = wgid / nig, fm = gid * WGM, gsz = (nM - fm) < WGM ? (nM - fm) : WGM;
        u.pm = fm + ((wgid % nig) % gsz); u.pn = (wgid % nig) / gsz; return true;
    }
};
typedef f32x4 Acc[2][2][4][2];
typedef int v4i_t __attribute__((ext_vector_type(4)));
struct PBase {
    const char* A; const char* Bt; int K, lda; Order ord; int dry = 0;
    static constexpr bool GATHER = false, MIDK = false, FP8 = false; static constexpr int MIDT = 0;
    __device__ __forceinline__ bool next(int i, Unit& u) const { return ord.next(i, u); }
    __device__ __forceinline__ const char* a_tile(const Unit& u) const { return A + (size_t)u.pm * 256 * lda * 2; }
    __device__ __forceinline__ const char* b_tile(const Unit& u) const { return Bt + (size_t)u.pn * 256 * K * 2; }
    __device__ __forceinline__ void a_offs(const Unit&, unsigned (&)[2][2], const int (&)[2], const int (&)[2]) const {}
    __device__ __forceinline__ void midscale(Acc&, int, ldsp, int, int) const {}
};

template <class P, bool ALIGN_EPI>
__device__ __forceinline__ void gemm_phase(ldsp lds, ldsp tab, const P& S) {
    int tid_ = threadIdx.x; asm volatile("" : "+v"(tid_));
    const int tid = tid_, wid = __builtin_amdgcn_readfirstlane(tid >> 6), lane = tid & 63, wr = wid >> 2, wc = wid & 3, fr = lane & 15, fq = lane >> 4;
    const int K = S.K, nt = K / BK, lda = S.lda;
    unsigned voffA[2], voffB[2]; int sR[2], sC[2];
#pragma unroll
    for (int i = 0; i < 2; ++i) { int R, C; stage_rc(tid * 16 + i * 8192, R, C); sR[i] = R; sC[i] = C; const int Rb = P::PERM ? ((R & ~31) + perm32(R & 31)) : R;
        voffA[i] = (unsigned)(R * lda + C) * 2u; voffB[i] = (unsigned)(Rb * K + C) * 2u; }
    const size_t kstep = (size_t)(BK * 2);
    const size_t hstepA = (size_t)HALF * lda * 2, hstepB = (size_t)HALF * K * 2;
    const unsigned ldsw = (unsigned)wid * 1024u;
    const int aoff = lds_byte(wr * 64 + fr, fq * 8), boff = lds_byte(wc * 32 + fr, fq * 8);
#define PG8_SA(b, h) (((b) * 2 + (h)) * HTB)
#define PG8_SB(b, h) ((4 + (b) * 2 + (h)) * HTB)
#define PG8_GL(src, bufoff, i) __builtin_amdgcn_global_load_lds((const unsigned*)(src), (LAS unsigned*)(lds + (bufoff) + ldsw + (i) * 8192), 16, 0, 0)
#define PG8_STAGEB(bufoff, gbase) do { _Pragma("unroll") for (int _i = 0; _i < 2; ++_i) PG8_GL((const char*)(gbase) + voffB[_i], bufoff, _i); } while (0)
#define PG8_STAGEA(bufoff, ubase, offs, h, kb) do { _Pragma("unroll") for (int _i = 0; _i < 2; ++_i) { \
        if constexpr (P::GATHER) PG8_GL(S.A + (size_t)(kb) + (offs)[h][_i], bufoff, _i); \
        else PG8_GL((const char*)(ubase) + (size_t)(h) * hstepA + (size_t)(kb) + voffA[_i], bufoff, _i); } } while (0)
#define PG8_LDA(dst, b, h) do { _Pragma("unroll") for (int m = 0; m < 4; ++m) _Pragma("unroll") for (int k = 0; k < 2; ++k) dst[m][k] = *(const LAS bf16x8*)(lds + PG8_SA(b, h) + aoff + m * 2048 + k * 1024); } while (0)
#define PG8_LDB(dst, b, h) do { _Pragma("unroll") for (int n = 0; n < 2; ++n) _Pragma("unroll") for (int k = 0; k < 2; ++k) dst[n][k] = *(const LAS bf16x8*)(lds + PG8_SB(b, h) + boff + n * 2048 + k * 1024); } while (0)
#define PG8_CAT8(x) __builtin_shufflevector(__builtin_bit_cast(v4i_t, (x)[0]), __builtin_bit_cast(v4i_t, (x)[1]), 0, 1, 2, 3, 4, 5, 6, 7)
#define PG8_MMA(ai, bj, At, Bt) do { __builtin_amdgcn_s_setprio(1); \
        if constexpr (P::FP8) { _Pragma("unroll") for (int m = 0; m < 4; ++m) _Pragma("unroll") for (int n = 0; n < 2; ++n) \
            asm volatile("v_mfma_scale_f32_16x16x128_f8f6f4 %0, %1, %2, %0, %3, %3 op_sel_hi:[0,0,0]" : "+v"(acc[ai][bj][m][n]) : "v"(PG8_CAT8(Bt[n])), "v"(PG8_CAT8(At[m])), "v"(sc8)); } \
        else { _Pragma("unroll") for (int m = 0; m < 4; ++m) _Pragma("unroll") for (int n = 0; n < 2; ++n) _Pragma("unroll") for (int k = 0; k < 2; ++k) \
            acc[ai][bj][m][n] = __builtin_amdgcn_mfma_f32_16x16x32_bf16(Bt[n][k], At[m][k], acc[ai][bj][m][n], 0, 0, 0); } \
        __builtin_amdgcn_s_setprio(0); } while (0)
#define PG8_MMAZ(ai, bj, At, Bt) do { __builtin_amdgcn_s_setprio(1); \
        if constexpr (P::FP8) { _Pragma("unroll") for (int m = 0; m < 4; ++m) _Pragma("unroll") for (int n = 0; n < 2; ++n) \
            asm volatile("v_mfma_scale_f32_16x16x128_f8f6f4 %0, %1, %2, 0, %3, %3 op_sel_hi:[0,0,0]" : "=&v"(acc[ai][bj][m][n]) : "v"(PG8_CAT8(Bt[n])), "v"(PG8_CAT8(At[m])), "v"(sc8)); } \
        else { _Pragma("unroll") for (int m = 0; m < 4; ++m) _Pragma("unroll") for (int n = 0; n < 2; ++n) { \
            acc[ai][bj][m][n] = __builtin_amdgcn_mfma_f32_16x16x32_bf16(Bt[n][0], At[m][0], (f32x4){0.f, 0.f, 0.f, 0.f}, 0, 0, 0); \
            acc[ai][bj][m][n] = __builtin_amdgcn_mfma_f32_16x16x32_bf16(Bt[n][1], At[m][1], acc[ai][bj][m][n], 0, 0, 0); } } \
        __builtin_amdgcn_s_setprio(0); } while (0)
#define PG8_WAIT_V(n) asm volatile("s_waitcnt vmcnt(" #n ")" ::: "memory")
#define PG8_WAIT_L(n) asm volatile("s_waitcnt lgkmcnt(" #n ")" ::: "memory")
#define PG8_BAR __builtin_amdgcn_s_barrier()
#define PG8_SCHED __builtin_amdgcn_sched_barrier(0)
#define PG8_TRIP(t, MF) do { \
            const bool last = (t == nt - 2); \
            asm volatile("" : "+v"(voffA[0]), "+v"(voffA[1]), "+v"(voffB[0]), "+v"(voffB[1])); \
            const size_t kb1 = (size_t)(t + 1) * kstep, kb2 = last ? (size_t)0 : (size_t)(t + 2) * kstep, kb3 = kb2 + kstep; \
            const char* uA2 = last ? nA : cA; const char* b2 = (last ? nB : cB) + kb2; const char* b3 = b2 + kstep; \
            unsigned o2[2][2]; \
            if constexpr (P::GATHER) { o2[0][0] = last ? gon[0][0] : goc[0][0]; o2[0][1] = last ? gon[0][1] : goc[0][1]; o2[1][0] = last ? gon[1][0] : goc[1][0]; o2[1][1] = last ? gon[1][1] : goc[1][1]; } \
            PG8_LDB(B0, 0, 0); PG8_LDB(B1, 0, 1); PG8_SCHED; PG8_LDA(At, 0, 0); PG8_STAGEA(PG8_SA(1, 1), cA, goc, 1, kb1); \
            PG8_WAIT_V(8); PG8_WAIT_L(0); PG8_BAR; MF(0, 0, At, B0); MF(0, 1, At, B1); PG8_BAR; PG8_SCHED; \
            PG8_LDA(At, 0, 1); PG8_STAGEB(PG8_SB(0, 0), b2); PG8_STAGEB(PG8_SB(0, 1), b2 + hstepB); PG8_STAGEA(PG8_SA(0, 0), uA2, o2, 0, kb2); \
            PG8_WAIT_V(8); PG8_WAIT_L(0); PG8_BAR; MF(1, 0, At, B0); MF(1, 1, At, B1); PG8_BAR; PG8_SCHED; \
            PG8_LDB(B0, 1, 0); PG8_LDB(B1, 1, 1); PG8_SCHED; PG8_LDA(At, 1, 0); PG8_STAGEA(PG8_SA(0, 1), uA2, o2, 1, kb2); \
            PG8_WAIT_V(8); PG8_WAIT_L(0); PG8_BAR; PG8_MMA(0, 0, At, B0); PG8_MMA(0, 1, At, B1); PG8_BAR; PG8_SCHED; \
            PG8_LDA(At, 1, 1); PG8_STAGEB(PG8_SB(1, 0), b3); PG8_STAGEB(PG8_SB(1, 1), b3 + hstepB); PG8_STAGEA(PG8_SA(1, 0), uA2, o2, 0, kb3); \
            PG8_WAIT_V(8); PG8_WAIT_L(0); PG8_BAR; PG8_MMA(1, 0, At, B0); PG8_MMA(1, 1, At, B1); PG8_BAR; PG8_SCHED; \
            if constexpr (P::MIDK) { if (t == P::MIDT - 2) S.midscale(acc, ui & 1, tab, wr, fr); } \
        } while (0)
    Unit cur, nxt; int ui = 0;
    if (!S.next(0, cur)) return;
    Acc acc;
    if constexpr (!P::FP8) {
#pragma unroll
        for (int a = 0; a < 2; ++a)
#pragma unroll
            for (int b = 0; b < 2; ++b)
#pragma unroll
                for (int m = 0; m < 4; ++m)
#pragma unroll
                    for (int n = 0; n < 2; ++n) acc[a][b][m][n] = (f32x4){0.f, 0.f, 0.f, 0.f}; }
    bf16x8 At[4][2], B0[2][2], B1[2][2];
    const int sc8 = 0x7F7F7F7F; (void)sc8;
    const char* cA = S.a_tile(cur); const char* cB = S.b_tile(cur);
    unsigned goc[2][2] = {{0u, 0u}, {0u, 0u}}, gon[2][2] = {{0u, 0u}, {0u, 0u}};
    if constexpr (P::GATHER) S.a_offs(cur, goc, sR, sC);
    S.prepare(cur, 0, tab);
    PG8_STAGEB(PG8_SB(0, 0), cB); PG8_STAGEB(PG8_SB(0, 1), cB + hstepB); PG8_STAGEA(PG8_SA(0, 0), cA, goc, 0, 0); PG8_STAGEA(PG8_SA(0, 1), cA, goc, 1, 0);
    if (wr == 1) PG8_BAR;
    PG8_WAIT_V(2); PG8_BAR;
    PG8_STAGEB(PG8_SB(1, 0), cB + kstep); PG8_STAGEA(PG8_SA(1, 0), cA, goc, 0, kstep); PG8_STAGEB(PG8_SB(1, 1), cB + hstepB + kstep);
    PG8_WAIT_V(6); PG8_BAR;
    for (;;) {
        const bool has_next = S.next(ui + 1, nxt);
        const char* nA = has_next ? S.a_tile(nxt) : cA; const char* nB = has_next ? S.b_tile(nxt) : cB;
        if constexpr (P::GATHER) { if (has_next) S.a_offs(nxt, gon, sR, sC); else { gon[0][0] = goc[0][0]; gon[0][1] = goc[0][1]; gon[1][0] = goc[1][0]; gon[1][1] = goc[1][1]; } }
        if constexpr (P::FP8) {
            PG8_TRIP(0, PG8_MMAZ);
            for (int t = 2; t < nt; t += 2) PG8_TRIP(t, PG8_MMA);
        } else {
            for (int t = 0; t < nt; t += 2) PG8_TRIP(t, PG8_MMA);
        }
        if constexpr (P::FP8) asm volatile("s_nop 15\n\ts_nop 15\n\ts_nop 15\n\ts_nop 15" ::: "memory");
        if constexpr (ALIGN_EPI) { if (wr == 0) PG8_BAR; }
        if (!S.dry) S.epi(acc, cur, ui & 1, tab, wr, wc, launder_v(fr), launder_v(fq));
        if (has_next && S.dry < 2) S.prepare(nxt, (ui + 1) & 1, tab);
        if (!has_next) break;
        if constexpr (!P::FP8) {
#pragma unroll
            for (int a = 0; a < 2; ++a)
#pragma unroll
                for (int b = 0; b < 2; ++b)
#pragma unroll
                    for (int m = 0; m < 4; ++m)
#pragma unroll
                        for (int n = 0; n < 2; ++n) acc[a][b][m][n] = (f32x4){0.f, 0.f, 0.f, 0.f}; }
        cur = nxt; cA = nA; cB = nB; ++ui;
        if constexpr (P::GATHER) { goc[0][0] = gon[0][0]; goc[0][1] = gon[0][1]; goc[1][0] = gon[1][0]; goc[1][1] = gon[1][1]; }
        if constexpr (ALIGN_EPI) { if (wr == 1) PG8_BAR; }
    }
    PG8_WAIT_V(0);
    if constexpr (!ALIGN_EPI) { if (wr == 0) PG8_BAR; }
    PG8_BAR;
#undef PG8_SA
#undef PG8_SB
#undef PG8_GL
#undef PG8_STAGEA
#undef PG8_STAGEB
#undef PG8_LDA
#undef PG8_LDB
#undef PG8_MMA
#undef PG8_MMAZ
#undef PG8_TRIP
#undef PG8_CAT8
#undef PG8_WAIT_V
#undef PG8_WAIT_L
#undef PG8_BAR
#undef PG8_SCHED
}
}

namespace prob {
using pg8::Acc; using pg8::Unit; using pg8::PBase;
__device__ __forceinline__ LAS float* T0(ldsp tab, int par) { return (LAS float*)(tab) + par * 256; }
__device__ __forceinline__ LAS float* T1(ldsp tab, int par) { return (LAS float*)(tab + 2048) + par * 256; }
__device__ __forceinline__ LAS int*   T2(ldsp tab, int par) { return (LAS int*)(tab + 4096) + par * 256; }
__device__ __forceinline__ LAS float* T3(ldsp tab, int par) { return (LAS float*)(tab + 6144) + par * 512; }
__device__ __forceinline__ u32x4 pack8(f32x4 a, f32x4 b) { u32x4 w; w.x = cvt_pk_bf16(a[0], a[1]); w.y = cvt_pk_bf16(a[2], a[3]); w.z = cvt_pk_bf16(b[0], b[1]); w.w = cvt_pk_bf16(b[2], b[3]); return w; }
__device__ __forceinline__ float dot4(f32x4 a) { return (a[0] * a[0] + a[1] * a[1]) + (a[2] * a[2] + a[3] * a[3]); }
__device__ __forceinline__ void rot8(f32x4& x1, f32x4& x2, const float* cosp, const float* sinp) {
    const f32x4 c = gld4(cosp), s = gld4(sinp); const f32x4 a = x1 * c - x2 * s, b = x2 * c + x1 * s; x1 = a; x2 = b; }

#define PROB_WS() unsigned char* w_ = ws; asm volatile("" : "+s"(w_))
struct PIn : PBase {
    static constexpr bool PERM = true;
    unsigned char* ws; int l;
    __device__ __forceinline__ void prepare(const Unit& u, int par, ldsp tab) const {
        PROB_WS(); const float* ssqx = (const float*)(w_ + WS_SSQX);
        const int tid = launder_v(threadIdx.x); if (tid < 256) { const int row = u.pm * 256 + tid; const float bvl = ((const float*)(w_ + WS_BIN))[((size_t)l * 2 + (u.pm >> 5)) * INP + u.pn * 256 + tid];
            T0(tab, par)[tid] = rsq_(sum16(ssqx + (size_t)row * 16) * (1.0f / 1024.0f) + EPS); T3(tab, par)[tid] = bvl; } }
    __device__ __forceinline__ void epi(const Acc& acc, const Unit& u, int par, ldsp tab, int wr, int wc, int fr, int fq) const {
        PROB_WS(); const float* cosT = (const float*)(w_ + WS_COS); const float* sinT = (const float*)(w_ + WS_SIN);
        bf16_t* proj = (bf16_t*)(w_ + WS_PROJ); float* ssql = (float*)(w_ + WS_SSQL);
        const LAS float* bp = T3(tab, par) + wc * 32 + 8 * fq;
        f32x4 bv[2][2];
#pragma unroll
        for (int bj = 0; bj < 2; ++bj)
#pragma unroll
            for (int n = 0; n < 2; ++n) bv[bj][n] = *(const LAS f32x4*)(bp + bj * 128 + 4 * n);
        const bool rope = (u.pn == 1 && wc == 0);
        f32x4 cs8[8], sn8[8];
        if (rope) {
#pragma unroll
            for (int g = 0; g < 8; ++g) { const size_t gr = (size_t)u.pm * 256 + (g >> 2) * 128 + wr * 64 + (g & 3) * 16 + fr; cs8[g] = gld4(cosT + gr * 16 + 4 * fq); sn8[g] = gld4(sinT + gr * 16 + 4 * fq); } }
#pragma unroll
        for (int ai = 0; ai < 2; ++ai)
#pragma unroll
            for (int m = 0; m < 4; ++m) { const int lr = ai * 128 + wr * 64 + m * 16 + fr; const float rs = T0(tab, par)[lr]; const size_t grow = (size_t)u.pm * 256 + lr;
                bf16_t* rowp = proj + grow * INP + u.pn * 256 + wc * 32 + 8 * fq; float s = 0.f;
#pragma unroll
                for (int bj = 0; bj < 2; ++bj) { f32x4 v0 = acc[ai][bj][m][0] * rs + bv[bj][0], v1 = acc[ai][bj][m][1] * rs + bv[bj][1];
                    if (bj == 1 && rope) { const f32x4 c = cs8[ai * 4 + m], s2 = sn8[ai * 4 + m]; const f32x4 a = v0 * c - v1 * s2, b2 = v1 * c + v0 * s2; v0 = a; v1 = b2; }
                    if (u.pn == 0 || bj == 0) s += dot4(v0) + dot4(v1);
                    gst16(rowp + bj * 128, pack8(v0, v1)); }
                if (u.pn <= 1) { s += __shfl_xor(s, 16); s += __shfl_xor(s, 32); if (fq == 0) ssql[grow * 8 + u.pn * 4 + wc] = s; } }
    }
};
struct PQ : PBase {
    static constexpr bool PERM = true;
    unsigned char* ws;
    __device__ __forceinline__ void prepare(const Unit& u, int par, ldsp tab) const {
        PROB_WS(); const float* ssql = (const float*)(w_ + WS_SSQL);
        const int tid = launder_v(threadIdx.x); if (tid < 256) { const int row = u.pm * 256 + tid; const f32x4 a = gld4(ssql + (size_t)row * 8); T0(tab, par)[tid] = rsq_(((a[0] + a[1]) + (a[2] + a[3])) * (1.0f / 256.0f) + EPS); } }
    __device__ __forceinline__ void epi(const Acc& acc, const Unit& u, int par, ldsp tab, int wr, int wc, int fr, int fq) const {
        PROB_WS(); const float* cosT = (const float*)(w_ + WS_COS); const float* sinT = (const float*)(w_ + WS_SIN); bf16_t* q = (bf16_t*)(w_ + WS_QMLA);
        const bool r0 = ((u.pn * 8 + wc) % 3 == 2), r1 = ((u.pn * 8 + 4 + wc) % 3 == 2);
        f32x4 cs8[8], sn8[8];
        if (r0 || r1) {
#pragma unroll
            for (int g = 0; g < 8; ++g) { const size_t gr = (size_t)u.pm * 256 + (g >> 2) * 128 + wr * 64 + (g & 3) * 16 + fr; cs8[g] = gld4(cosT + gr * 16 + 4 * fq); sn8[g] = gld4(sinT + gr * 16 + 4 * fq); } }
#pragma unroll
        for (int ai = 0; ai < 2; ++ai)
#pragma unroll
            for (int m = 0; m < 4; ++m) { const int lr = ai * 128 + wr * 64 + m * 16 + fr; const float rs = T0(tab, par)[lr]; const size_t grow = (size_t)u.pm * 256 + lr;
                bf16_t* rowp = q + grow * QW + u.pn * 256 + wc * 32 + 8 * fq;
#pragma unroll
                for (int bj = 0; bj < 2; ++bj) { f32x4 v0 = acc[ai][bj][m][0] * rs, v1 = acc[ai][bj][m][1] * rs;
                    if (bj == 0 ? r0 : r1) { const f32x4 c = cs8[ai * 4 + m], s2 = sn8[ai * 4 + m]; const f32x4 a = v0 * c - v1 * s2, b2 = v1 * c + v0 * s2; v0 = a; v1 = b2; }
                    gst16(rowp + bj * 128, pack8(v0, v1)); } }
    }
};
struct PKV : PBase {
    static constexpr bool PERM = true;
    unsigned char* ws;
    __device__ __forceinline__ void prepare(const Unit& u, int par, ldsp tab) const {
        PROB_WS(); const float* ssql = (const float*)(w_ + WS_SSQL);
        const int tid = launder_v(threadIdx.x); if (tid < 256) { const int row = u.pm * 256 + tid; const f32x4 a = gld4(ssql + (size_t)row * 8 + 4); T0(tab, par)[tid] = rsq_(((a[0] + a[1]) + (a[2] + a[3])) * (1.0f / 128.0f) + EPS); } }
    __device__ __forceinline__ void epi(const Acc& acc, const Unit& u, int par, ldsp tab, int wr, int wc, int fr, int fq) const {
        PROB_WS(); bf16_t* kv = (bf16_t*)(w_ + WS_KV);
#pragma unroll
        for (int ai = 0; ai < 2; ++ai)
#pragma unroll
            for (int m = 0; m < 4; ++m) { const int lr = ai * 128 + wr * 64 + m * 16 + fr; const float rs = T0(tab, par)[lr]; const size_t grow = (size_t)u.pm * 256 + lr;
                bf16_t* rowp = kv + grow * KVW + u.pn * 256 + wc * 32 + 8 * fq;
#pragma unroll
                for (int bj = 0; bj < 2; ++bj) gst16(rowp + bj * 128, pack8(acc[ai][bj][m][0] * rs, acc[ai][bj][m][1] * rs)); }
    }
};
__device__ __forceinline__ void epi_resid(const Acc& acc, const Unit& u, LAS const float* rsT, bf16_t* X, const float* gate, const float* gsn, bf16_t* anext, bool out8, float* ssqx, int wr, int wc, int fr, int fq) {
    const int b = u.pm >> 5; const int col0 = u.pn * 256 + wc * 32 + 8 * fq;
    float s[8];
#pragma unroll
    for (int j = 0; j < 8; ++j) s[j] = 0.f;
    u32x4 xq[2][4]; f32x4 gtq[2][2], gnq[2][2];
#pragma unroll
    for (int bj = 0; bj < 2; ++bj)
#pragma unroll
        for (int n = 0; n < 2; ++n) { gtq[bj][n] = gld4(gate + b * 1024 + col0 + bj * 128 + 4 * n); gnq[bj][n] = gld4(gsn + b * 1024 + col0 + bj * 128 + 4 * n); }
#define ER_LOAD(k) do { const int bj_ = (k) >> 1, ai_ = (k) & 1; \
        _Pragma("unroll") for (int g = 0; g < 4; ++g) xq[(k) & 1][g] = *(const GAS u32x4*)(X + ((size_t)u.pm * 256 + ai_ * 128 + wr * 64 + g * 16 + fr) * 1024 + col0 + bj_ * 128); } while (0)
    ER_LOAD(0);
#pragma unroll
    for (int k = 0; k < 4; ++k) { const int bj = k >> 1, ai = k & 1; const int co = col0 + bj * 128;
        if (k + 1 < 4) ER_LOAD(k + 1);
        __builtin_amdgcn_sched_barrier(0);
#pragma unroll
        for (int m = 0; m < 4; ++m) { const int lr = ai * 128 + wr * 64 + m * 16 + fr; const float rs = rsT ? rsT[lr] : 1.0f; const size_t off = ((size_t)u.pm * 256 + lr) * 1024 + co;
            const u32x4 xr = xq[k & 1][m];
            const f32x4 x0 = (f32x4){bf_lo(xr.x), bf_hi(xr.x), bf_lo(xr.y), bf_hi(xr.y)}, x1 = (f32x4){bf_lo(xr.z), bf_hi(xr.z), bf_lo(xr.w), bf_hi(xr.w)};
            const f32x4 n0 = x0 + gtq[bj][0] * (acc[ai][bj][m][0] * rs), n1 = x1 + gtq[bj][1] * (acc[ai][bj][m][1] * rs);
            gst16(X + off, pack8(n0, n1)); s[ai * 4 + m] += dot4(n0) + dot4(n1);
            const f32x4 a0 = n0 * gnq[bj][0], a1 = n1 * gnq[bj][1];
            if (out8) { u32x2 w8; w8.x = cvt4_fp8(a0[0], a0[1], a0[2], a0[3]); w8.y = cvt4_fp8(a1[0], a1[1], a1[2], a1[3]); gst8((unsigned char*)anext + off, w8); }
            else gst16(anext + off, pack8(a0, a1)); }
        __builtin_amdgcn_sched_barrier(0); }
#undef ER_LOAD
#pragma unroll
    for (int ai = 0; ai < 2; ++ai)
#pragma unroll
        for (int m = 0; m < 4; ++m) { const int lr = ai * 128 + wr * 64 + m * 16 + fr; float q = s[ai * 4 + m]; q += __shfl_xor(q, 16); q += __shfl_xor(q, 32);
            if (fq == 0) ssqx[((size_t)u.pm * 256 + lr) * 16 + u.pn * 4 + wc] = q; }
}
struct POut : PBase {
    static constexpr bool PERM = true, MIDK = true; static constexpr int MIDT = 8;
    unsigned char* ws; int l; const float* xin0;
    __device__ __forceinline__ void prepare(const Unit& u, int par, ldsp tab) const {
        PROB_WS(); const float* ssqo = (const float*)(w_ + WS_SSQO);
        const int tid = launder_v(threadIdx.x); if (tid < 256) { const float* p = ssqo + ((size_t)u.pm * 256 + tid) * 16; const f32x4 a = gld4(p), b = gld4(p + 4), c = gld4(p + 8), d = gld4(p + 12);
            const float sm = ((a[0] + a[1]) + (a[2] + a[3])) + ((b[0] + b[1]) + (b[2] + b[3])), ss = ((c[0] + c[1]) + (c[2] + c[3])) + ((d[0] + d[1]) + (d[2] + d[3]));
            const float rm = rsq_(sm * (1.0f / 512.0f) + EPS), rsb = rsq_(ss * (1.0f / 512.0f) + EPS);
            T0(tab, par)[tid] = rsb; T1(tab, par)[tid] = rm / rsb; } }
    __device__ __forceinline__ void midscale(Acc& acc, int par, ldsp tab, int wr, int fr) const {
#pragma unroll
        for (int ai = 0; ai < 2; ++ai)
#pragma unroll
            for (int m = 0; m < 4; ++m) { const float f = T1(tab, par)[ai * 128 + wr * 64 + m * 16 + fr];
#pragma unroll
                for (int bj = 0; bj < 2; ++bj)
#pragma unroll
                    for (int n = 0; n < 2; ++n) acc[ai][bj][m][n] = acc[ai][bj][m][n] * f; } }
    __device__ __forceinline__ void epi(const Acc& acc, const Unit& u, int par, ldsp tab, int wr, int wc, int fr, int fq) const {
        PROB_WS(); bf16_t* X = (bf16_t*)(w_ + WS_X); const float* gs = (const float*)(w_ + WS_GS) + (size_t)l * 4 * 2048;
        epi_resid(acc, u, T0(tab, par), X, gs + 1 * 2048, gs + 2 * 2048, (bf16_t*)(w_ + WS_AFFN), (l & 1) != 0, (float*)(w_ + WS_SSQX), wr, wc, fr, fq); }
};
struct PDown : PBase {
    static constexpr bool PERM = true;
    unsigned char* ws; int l;
    __device__ __forceinline__ void prepare(const Unit&, int, ldsp) const {}
    __device__ __forceinline__ void epi(const Acc& acc, const Unit& u, int, ldsp, int wr, int wc, int fr, int fq) const {
        PROB_WS(); bf16_t* X = (bf16_t*)(w_ + WS_X); const float* gs = (const float*)(w_ + WS_GS) + (size_t)l * 4 * 2048;
        epi_resid(acc, u, (LAS const float*)nullptr, X, gs + 3 * 2048, gs + 4 * 2048  , (bf16_t*)(w_ + WS_AMIX), false, (float*)(w_ + WS_SSQX), wr, wc, fr, fq); }
};
struct PGU : PBase {
    static constexpr bool PERM = true;
    unsigned char* ws; int i;
    __device__ __forceinline__ void prepare(const Unit& u, int par, ldsp tab) const {
        PROB_WS(); const float* ssqx = (const float*)(w_ + WS_SSQX);
        const int tid = launder_v(threadIdx.x); if (tid < 256) { const int row = u.pm * 256 + tid; const float bvl = ((const float*)(w_ + WS_BGU))[((size_t)i * 2 + (u.pm >> 5)) * (2 * DFF) + u.pn * 256 + tid];
            T0(tab, par)[tid] = rsq_(sum16(ssqx + (size_t)row * 16) * (1.0f / 1024.0f) + EPS); T3(tab, par)[tid] = bvl; } }
    __device__ __forceinline__ void epi(const Acc& acc, const Unit& u, int par, ldsp tab, int wr, int wc, int fr, int fq) const {
        PROB_WS(); bf16_t* act = (bf16_t*)(w_ + WS_ACT);
        const LAS float* bp = T3(tab, par) + wc * 32 + 8 * fq;
        f32x4 bg[2], bu[2];
#pragma unroll
        for (int n = 0; n < 2; ++n) { bg[n] = *(const LAS f32x4*)(bp + 4 * n); bu[n] = *(const LAS f32x4*)(bp + 128 + 4 * n); }
#pragma unroll
        for (int ai = 0; ai < 2; ++ai)
#pragma unroll
            for (int m = 0; m < 4; ++m) { const int lr = ai * 128 + wr * 64 + m * 16 + fr; const float rs = T0(tab, par)[lr]; const size_t grow = (size_t)u.pm * 256 + lr;
                const f32x4 g0 = acc[ai][0][m][0] * rs + bg[0], g1 = acc[ai][0][m][1] * rs + bg[1], u0 = acc[ai][1][m][0] * rs + bu[0], u1 = acc[ai][1][m][1] * rs + bu[1];
                const f32x4 t0 = g0 * (-LOG2E), t1 = g1 * (-LOG2E); f32x4 e0, e1;
#pragma unroll
                for (int j = 0; j < 4; ++j) { e0[j] = ex2(t0[j]); e1[j] = ex2(t1[j]); }
                const f32x4 d0 = e0 + 1.0f, d1 = e1 + 1.0f; f32x4 r0, r1;
#pragma unroll
                for (int j = 0; j < 4; ++j) { r0[j] = rcpf_(d0[j]); r1[j] = rcpf_(d1[j]); }
                f32x4 h[2]; h[0] = (g0 * u0) * r0; h[1] = (g1 * u1) * r1;
                gst16(act + grow * DFF + u.pn * 128 + wc * 32 + 8 * fq, pack8(h[0], h[1])); }
    }
};
struct MoeTab { LAS int* p;
    __device__ __forceinline__ int ntiles() const { return p[8]; }
    __device__ __forceinline__ void locate(int pm, int& e, int& lt) const { int ee = 0;
#pragma unroll
        for (int j = 1; j < 8; ++j) ee += (pm >= p[j]) ? 1 : 0;
        e = ee; lt = pm - p[ee]; }
};
struct PEGU : PBase {
    static constexpr bool PERM = true, GATHER = true, FP8 = true;
    MoeTab mt; unsigned char* ws; int i;
    __device__ __forceinline__ bool next(int i_, Unit& u) const { const bool r = ord.next(i_, u); if (r) mt.locate(u.pm, u.e, u.lt); return r; }
    __device__ __forceinline__ const char* b_tile(const Unit& u) const { return Bt + ((size_t)u.e * (2 * DFE) + (size_t)u.pn * 256) * 1024; }
    __device__ __forceinline__ void a_offs(const Unit& u, unsigned (&off)[2][2], const int (&sR)[2], const int (&sC)[2]) const { const int e = u.e, lt = u.lt; const int cnt = mt.p[32 + e];
        PROB_WS(); const int* rowtok = (const int*)(w_ + WS_ROWTOK);
#pragma unroll
        for (int h = 0; h < 2; ++h)
#pragma unroll
            for (int i2 = 0; i2 < 2; ++i2) { const int idx = lt * 256 + h * 128 + sR[i2]; const int tok = idx < cnt ? (rowtok[(size_t)e * MT + idx] >> 1) : 0; off[h][i2] = (unsigned)(tok * 512 + sC[i2]) * 2u; } }
    __device__ __forceinline__ void prepare(const Unit& u, int par, ldsp tab) const {
        PROB_WS(); const GAS int* rowtok = (const GAS int*)(w_ + WS_ROWTOK); const GAS float* roww = (const GAS float*)(w_ + WS_ROWW); const GAS float* rowr = (const GAS float*)(w_ + WS_ROWR);
        const int tid = launder_v(threadIdx.x); const int e = u.e, lt = u.lt;
        const GAS float* bias = (const GAS float*)(w_ + WS_BEGU) + ((size_t)i * NE + e) * 2 * (2 * DFE) + (size_t)(tid >> 8) * (2 * DFE) + u.pn * 256;
        const float bv = bias[tid & 255];
        int rt = -1; float r = 0.f, w = 0.f;
        if (tid < 256) { const int idx = lt * 256 + tid; if (idx < mt.p[32 + e]) { const size_t o = (size_t)e * MT + idx; rt = rowtok[o]; r = rowr[o]; w = roww[o]; } }
        T3(tab, par)[tid] = bv;
        if (tid < 256) { T2(tab, par)[tid] = rt; T0(tab, par)[tid] = r * (1.0f / W8_SCALE); T1(tab, par)[tid] = w * H8_SCALE; } }
    __device__ __forceinline__ void epi(const Acc& acc, const Unit& u, int par, ldsp tab, int wr, int wc, int fr, int fq) const {
        PROB_WS(); unsigned char* act = w_ + WS_ACT;
        const size_t pos0 = (size_t)mt.p[16 + u.e] + (size_t)u.lt * 256;
        const LAS float* bpe = T3(tab, par) + wc * 32 + 8 * fq;
        int rtv[8]; float rsv[8], wv[8];
#pragma unroll
        for (int g = 0; g < 8; ++g) { const int lr = (g >> 2) * 128 + wr * 64 + (g & 3) * 16 + fr; rtv[g] = T2(tab, par)[lr]; rsv[g] = T0(tab, par)[lr]; wv[g] = T1(tab, par)[lr]; }
#pragma unroll
        for (int ai = 0; ai < 2; ++ai)
#pragma unroll
            for (int m = 0; m < 4; ++m) { const int lr = ai * 128 + wr * 64 + m * 16 + fr; const int rt = rtv[ai * 4 + m];
                { const float rs = rsv[ai * 4 + m], w = wv[ai * 4 + m]; const LAS float* bp = bpe + ((rt >= 0 ? rt : 0) >> 14) * 256;
                    const f32x4 g0 = acc[ai][0][m][0] * rs + *(const LAS f32x4*)(bp), g1 = acc[ai][0][m][1] * rs + *(const LAS f32x4*)(bp + 4);
                    const f32x4 u0 = (acc[ai][1][m][0] * rs + *(const LAS f32x4*)(bp + 128)) * w, u1 = (acc[ai][1][m][1] * rs + *(const LAS f32x4*)(bp + 132)) * w;
                    const f32x4 t0 = g0 * (-LOG2E), t1 = g1 * (-LOG2E);
                    f32x4 e0, e1;
#pragma unroll
                    for (int j = 0; j < 4; ++j) { e0[j] = ex2(t0[j]); e1[j] = ex2(t1[j]); }
                    const f32x4 d0 = e0 + 1.0f, d1 = e1 + 1.0f; f32x4 r0, r1;
#pragma unroll
                    for (int j = 0; j < 4; ++j) { r0[j] = rcpf_(d0[j]); r1[j] = rcpf_(d1[j]); }
                    f32x4 h[2]; h[0] = (g0 * u0) * r0; h[1] = (g1 * u1) * r1;
                    u32x2 o8; o8.x = cvt4_fp8(h[0][0], h[0][1], h[0][2], h[0][3]); o8.y = cvt4_fp8(h[1][0], h[1][1], h[1][2], h[1][3]);
                    if (rt >= 0) gst8(act + (pos0 + lr) * DFE + u.pn * 128 + wc * 32 + 8 * fq, o8); } }
    }
};
struct PED : PBase {
    static constexpr bool PERM = true, FP8 = true;
    MoeTab mt; unsigned char* ws;
    __device__ __forceinline__ bool next(int i_, Unit& u) const { const bool r = ord.next(i_, u); if (r) mt.locate(u.pm, u.e, u.lt); return r; }
    __device__ __forceinline__ const char* a_tile(const Unit& u) const { return A + ((size_t)mt.p[16 + u.e] + (size_t)u.lt * 256) * DFE; }
    __device__ __forceinline__ const char* b_tile(const Unit& u) const { return Bt + ((size_t)u.e * 1024 + (size_t)u.pn * 256) * DFE; }
    __device__ __forceinline__ void prepare(const Unit& u, int par, ldsp tab) const {
        PROB_WS(); const int* rowtok = (const int*)(w_ + WS_ROWTOK);
        const int tid = launder_v(threadIdx.x); if (tid < 256) { const int e = u.e, lt = u.lt; const int idx = lt * 256 + tid; T2(tab, par)[tid] = idx < mt.p[32 + e] ? rowtok[(size_t)e * MT + idx] : -1; } }
    __device__ __forceinline__ void epi(const Acc& acc, const Unit& u, int par, ldsp tab, int wr, int wc, int fr, int fq) const {
        PROB_WS(); bf16_t* y = (bf16_t*)(w_ + WS_Y);
        int rtv[8];
#pragma unroll
        for (int g = 0; g < 8; ++g) rtv[g] = T2(tab, par)[(g >> 2) * 128 + wr * 64 + (g & 3) * 16 + fr];
#pragma unroll
        for (int ai = 0; ai < 2; ++ai)
#pragma unroll
            for (int m = 0; m < 4; ++m) { const int rt = rtv[ai * 4 + m];
                if (rt >= 0) { bf16_t* rowp = y + (size_t)rt * 1024 + u.pn * 256 + wc * 32 + 8 * fq;
#pragma unroll
                    for (int bj = 0; bj < 2; ++bj) gst16(rowp + bj * 128, pack8(acc[ai][bj][m][0] * (1.0f / (W8_SCALE * H8_SCALE)), acc[ai][bj][m][1] * (1.0f / (W8_SCALE * H8_SCALE)))); } }
    }
};
#undef PROB_WS
}

namespace att {
typedef short v4i16_t __attribute__((ext_vector_type(4)));
__device__ __forceinline__ int crow(int r, int hi) { return (r & 3) + 8 * (r >> 2) + 4 * hi; }
#define ATT_WAITBAR() asm volatile("s_waitcnt vmcnt(0) lgkmcnt(0)\n\ts_barrier" ::: "memory")
__device__ __forceinline__ void glds(const void* g, ldsp l) { __builtin_amdgcn_global_load_lds((const unsigned*)g, (LAS unsigned*)l, 16, 0, 0); }
__device__ __forceinline__ f32x16 mfma32(bf16x8 a, bf16x8 b, f32x16 c) { return __builtin_amdgcn_mfma_f32_32x32x16_bf16(a, b, c, 0, 0, 0); }
__device__ __forceinline__ s16x4 vtr(const LAS unsigned char* p) { return __builtin_bit_cast(s16x4, __builtin_amdgcn_ds_read_tr16_b64_v4i16((LAS v4i16_t*)p)); }
__device__ __forceinline__ float swapmax(float m) { auto rr = __builtin_amdgcn_permlane32_swap(__float_as_uint(m), __float_as_uint(m), false, false); return fmaxf(__uint_as_float(rr[0]), __uint_as_float(rr[1])); }
__device__ __forceinline__ float swapsum(float m) { auto rr = __builtin_amdgcn_permlane32_swap(__float_as_uint(m), __float_as_uint(m), false, false); return __uint_as_float(rr[0]) + __uint_as_float(rr[1]); }
#define ATT_MX3(a, b, c) __builtin_fmaxf(__builtin_fmaxf((a), (b)), (c))
__device__ __forceinline__ float rowmax(const f32x16& p0, const f32x16& p1) {
    float a = ATT_MX3(p0[0], p0[1], p1[0]), b = ATT_MX3(p0[2], p0[3], p1[1]); a = ATT_MX3(a, p1[2], p1[3]);
#pragma unroll
    for (int r = 4; r < 16; r += 4) { a = ATT_MX3(a, p0[r], p0[r + 1]); b = ATT_MX3(b, p0[r + 2], p0[r + 3]); a = ATT_MX3(a, p1[r], p1[r + 1]); b = ATT_MX3(b, p1[r + 2], p1[r + 3]); }
    return swapmax(__builtin_fmaxf(a, b));
}
__device__ __forceinline__ u32x4 packp(const f32x16& p, int b) { u32x4 w; w.x = cvt_pk_bf16(p[b], p[b + 1]); w.y = cvt_pk_bf16(p[b + 2], p[b + 3]); w.z = cvt_pk_bf16(p[b + 4], p[b + 5]); w.w = cvt_pk_bf16(p[b + 6], p[b + 7]); return w; }
__device__ __forceinline__ void pv(f32x16 (&o)[2], const LAS unsigned char* vp, u32x4 pw0, u32x4 pw1, u32x4 pw2, u32x4 pw3) {
#pragma unroll
    for (int d0 = 0; d0 < 2; ++d0) {
        s16x4 lo[4], hi4[4];
#pragma unroll
        for (int ks = 0; ks < 4; ++ks) { lo[ks] = vtr(vp + d0 * 4096 + ks * 1024); hi4[ks] = vtr(vp + d0 * 4096 + ks * 1024 + 512); }
#define ATT_PK(k) (bf16x8){lo[k][0], lo[k][1], lo[k][2], lo[k][3], hi4[k][0], hi4[k][1], hi4[k][2], hi4[k][3]}
        o[d0] = mfma32(__builtin_bit_cast(bf16x8, pw0), ATT_PK(0), o[d0]);
        o[d0] = mfma32(__builtin_bit_cast(bf16x8, pw1), ATT_PK(1), o[d0]);
        o[d0] = mfma32(__builtin_bit_cast(bf16x8, pw2), ATT_PK(2), o[d0]);
        o[d0] = mfma32(__builtin_bit_cast(bf16x8, pw3), ATT_PK(3), o[d0]);
#undef ATT_PK
    }
}
__device__ __forceinline__ void store_o(const f32x16 (&o)[2], const float (&sc)[16], bf16_t* Ow, float* ssq  , ldsp stg, int lane, int r32, int hi) {
    LAS bf16_t* s = (LAS bf16_t*)stg;
#pragma unroll
    for (int r = 0; r < 16; ++r) { const int orow = crow(r, hi);
#pragma unroll
        for (int d0 = 0; d0 < 2; ++d0) s[orow * 64 + d0 * 32 + r32] = (bf16_t)(cvt_pk_bf16(o[d0][r] * sc[r], 0.f) & 0xffffu); }
    asm volatile("s_waitcnt lgkmcnt(0)" ::: "memory");
#pragma unroll
    for (int i = 0; i < 4; ++i) { const int row = i * 8 + (lane >> 3), ch = lane & 7; const u32x4 v = *(const LAS u32x4*)(s + row * 64 + ch * 8);
        gst16(Ow + (size_t)row * 1024 + ch * 8, v);
        float q = 0.f;
#pragma unroll
        for (int j = 0; j < 4; ++j) { const float a = bf_lo(v[j]), b = bf_hi(v[j]); q += a * a + b * b; }
        q += __shfl_xor(q, 1); q += __shfl_xor(q, 2); q += __shfl_xor(q, 4);
        if (ch == 0) ssq[(size_t)row * 16] = q; }
}
constexpr int KS_MLA = 12288, NRING = 4, VOFF = NRING * KS_MLA, VS = 8192, WSF_OFF = VOFF + NRING * VS, OST_OFF = WSF_OFF + 8 * 256, ATT_LDS = OST_OFF + 8 * 4096;
static_assert(ATT_LDS <= RING_BYTES, "attention LDS");

#define SGB(mask, n) __builtin_amdgcn_sched_group_barrier(mask, n, 0)
__device__ __forceinline__ void mla_unit(int b, int h, int qb, const bf16_t* __restrict__ Q, const bf16_t* __restrict__ KV, const bf16_t* __restrict__ PROJ, bf16_t* OCAT, float* SSQO, ldsp shm) {
    const int tid = launder_v(threadIdx.x), lane = tid & 63, r32 = lane & 31, hi = lane >> 5; const int wid = __builtin_amdgcn_readfirstlane(tid >> 6);
    const size_t rowbase = (size_t)b * SEQ; const int q0 = qb * 256;
    const bf16_t* ksrc = KV + (rowbase + lane) * KVW + h * 128 + wid * 8;
    const bf16_t* rsrc = PROJ + (rowbase + lane) * INP + 384 + (wid & 3) * 8;
    const bf16_t* vsrc = KV + (rowbase + 16 * (wid & 3) + (lane >> 2)) * KVW + h * 128 + 64 + (wid >> 2) * 32 + (lane & 3) * 8;
    const int NT = 4 * qb + 4, NTw = 4 * qb + 1 + (wid >> 1);
#define MLA_DMAK(t, s) do { glds(ksrc + (size_t)(t) * 64 * KVW, shm + (s) * KS_MLA + wid * 1024); if (wid < 4) glds(rsrc + (size_t)(t) * 64 * INP, shm + (s) * KS_MLA + (8 + wid) * 1024); } while (0)
#define MLA_DMAV(t, s) glds(vsrc + (size_t)(t) * 64 * KVW, shm + VOFF + (s) * VS + wid * 1024)
#define MLA_WAITBAR() do { if (wid < 4) asm volatile("s_waitcnt vmcnt(6) lgkmcnt(0)\n\ts_barrier" ::: "memory"); else asm volatile("s_waitcnt vmcnt(4) lgkmcnt(0)\n\ts_barrier" ::: "memory"); } while (0)
#define MLA_ISSUE(s) do { const int tk_ = (s) + 3 < NT - 1 ? (s) + 3 : NT - 1, tv_ = (s) + 2 < 0 ? 0 : ((s) + 2 < NT - 1 ? (s) + 2 : NT - 1); MLA_DMAK(tk_, ((s) + 3) & 3); MLA_DMAV(tv_, ((s) + 2) & 3); } while (0)
    MLA_ISSUE(-3); MLA_ISSUE(-2); MLA_ISSUE(-1);
    bf16x8 qr[6];
    { const bf16_t* Qw = Q + (rowbase + q0 + wid * 32 + r32) * QW + h * 96 + hi * 8;
#pragma unroll
      for (int d0 = 0; d0 < 6; ++d0) qr[d0] = *(const GAS bf16x8*)(Qw + d0 * 16); }
    asm volatile("s_waitcnt vmcnt(0)" ::: "memory");
    LAS float* wsf = (LAS float*)(shm + WSF_OFF) + wid * 64;
    const LAS unsigned char* vp0 = shm + VOFF + ((lane >> 4) & 1) * 32 + (lane & 3) * 8 + (4 * hi + ((lane & 15) >> 2)) * 64;
    const LAS unsigned char* kp0 = shm + hi * 1024 + r32 * 16;
    float mhat = 0.f, l_reg = 0.f; f32x16 o[2]; o[0] = f32x16{}; o[1] = f32x16{}; f32x16 negm = f32x16{};
    f32x16 pA0, pA1, pB0, pB1;
#define SBAR() __builtin_amdgcn_sched_barrier(0)
#define PIN(x) asm volatile("" : "+v"(x))
    MLA_WAITBAR();
    MLA_ISSUE(0);
    { const LAS unsigned char* kb = kp0; pA0 = f32x16{}; pA1 = f32x16{};
#pragma unroll
      for (int d0 = 0; d0 < 6; ++d0) { const bf16x8 k0 = *(const LAS bf16x8*)(kb + d0 * 2048), k1 = *(const LAS bf16x8*)(kb + d0 * 2048 + 512); pA0 = mfma32(k0, qr[d0], pA0); pA1 = mfma32(k1, qr[d0], pA1); }
      mhat = rowmax(pA0, pA1);
#pragma unroll
      for (int r = 0; r < 16; ++r) { negm[r] = -mhat; pA0[r] = ex2(pA0[r] - mhat); pA1[r] = ex2(pA1[r] - mhat); } }
    PIN(negm);
#define KRD(i) kf[i] = *(const LAS bf16x8*)(kb + ((i) >> 1) * 2048 + ((i) & 1) * 512)
#define VRD(i) do { vlo[i] = vtr(vp + ((i) >> 2) * 4096 + ((i) & 3) * 1024); vhi[i] = vtr(vp + ((i) >> 2) * 4096 + ((i) & 3) * 1024 + 512); } while (0)
#define MLA_VF(i) (bf16x8){vlo[i][0], vlo[i][1], vlo[i][2], vlo[i][3], vhi[i][0], vhi[i][1], vhi[i][2], vhi[i][3]}
#define GAPA(MF, LD, a0, a1, a2, a3, W0, W1, PW) do { MF; LD; sacc += a0; sacc += a1; sacc += a2; sacc += a3; PIN(sacc); W0; W1; PIN(PW); SBAR(); } while (0)
#define GAPB(MF, X, q) do { MF; X[q] = ex2(X[q]); X[(q) + 1] = ex2(X[(q) + 1]); X[(q) + 2] = ex2(X[(q) + 2]); X[(q) + 3] = ex2(X[(q) + 3]); PIN(X); SBAR(); } while (0)
#define PKW(P, q) cvt_pk_bf16(P[q], P[(q) + 1])
#define PAF(w) __builtin_bit_cast(bf16x8, w)
#define STEP(C0, C1, P0, P1, t) do { \
        MLA_WAITBAR(); MLA_ISSUE(t); \
        const LAS unsigned char* kb = kp0 + ((t) & 3) * KS_MLA; const LAS unsigned char* vp = vp0 + (((t) - 1) & 3) * VS; \
        bf16x8 kf[12]; s16x4 vlo[8], vhi[8]; u32x4 pw0, pw1, pw2, pw3; \
        SBAR(); KRD(0); KRD(1); KRD(2); KRD(3); SBAR(); __builtin_amdgcn_s_setprio(1); \
        float sacc = P0[0] + P0[1]; \
        GAPA(C0 = mfma32(kf[0], qr[0], negm), do { KRD(4); VRD(0); } while (0), P0[2], P0[3], P0[4], P0[5],       pw0.x = PKW(P0, 0),  pw0.y = PKW(P0, 2),  pw0); \
        GAPA(C1 = mfma32(kf[1], qr[0], negm), do { KRD(5); VRD(4); } while (0), P0[6], P0[7], P0[8], P0[9],       pw0.z = PKW(P0, 4),  pw0.w = PKW(P0, 6),  pw0); \
        GAPA(C0 = mfma32(kf[2], qr[1], C0),   do { KRD(6); VRD(1); } while (0), P0[10], P0[11], P0[12], P0[13],   pw1.x = PKW(P0, 8),  pw1.y = PKW(P0, 10), pw1); \
        GAPA(C1 = mfma32(kf[3], qr[1], C1),   do { KRD(7); VRD(5); } while (0), P0[14], P0[15], P1[0], P1[1],     pw1.z = PKW(P0, 12), pw1.w = PKW(P0, 14), pw1); \
        GAPA(C0 = mfma32(kf[4], qr[2], C0),   do { KRD(8); VRD(2); } while (0), P1[2], P1[3], P1[4], P1[5],       pw2.x = PKW(P1, 0),  pw2.y = PKW(P1, 2),  pw2); \
        GAPA(C1 = mfma32(kf[5], qr[2], C1),   do { KRD(9); VRD(6); } while (0), P1[6], P1[7], P1[8], P1[9],       pw2.z = PKW(P1, 4),  pw2.w = PKW(P1, 6),  pw2); \
        GAPA(C0 = mfma32(kf[6], qr[3], C0),   do { KRD(10); VRD(3); } while (0), P1[10], P1[11], P1[12], P1[13],  pw3.x = PKW(P1, 8),  pw3.y = PKW(P1, 10), pw3); \
        GAPA(C1 = mfma32(kf[7], qr[3], C1),   do { KRD(11); VRD(7); } while (0), P1[14], P1[15], 0.f, 0.f,        pw3.z = PKW(P1, 12), pw3.w = PKW(P1, 14), pw3); \
        C0 = mfma32(kf[8], qr[4], C0); SBAR(); C1 = mfma32(kf[9], qr[4], C1); SBAR(); C0 = mfma32(kf[10], qr[5], C0); SBAR(); C1 = mfma32(kf[11], qr[5], C1); SBAR(); \
        __builtin_amdgcn_s_setprio(0); l_reg += sacc; \
        if (__builtin_expect((t) >= NTw, 0)) { asm volatile("" ::: "memory"); _Pragma("unroll") for (int r = 0; r < 16; ++r) { C0[r] = -INFINITY; C1[r] = -INFINITY; } PIN(C0); PIN(C1); } \
        bool resc = false; \
        { const float rm = rowmax(C0, C1); \
          if (__builtin_expect(__any(rm > 8.0f), 0)) { const float dl = fmaxf(rm, 0.f); mhat += dl; \
              _Pragma("unroll") for (int r = 0; r < 16; ++r) { C0[r] -= dl; C1[r] -= dl; negm[r] = -mhat; } PIN(negm); \
              const float f = ex2(-dl); l_reg *= f; if (hi == 0) wsf[r32] = f; resc = true; } } \
        SBAR(); \
        GAPB(o[0] = mfma32(PAF(pw0), MLA_VF(0), o[0]), C0, 0); \
        GAPB(o[1] = mfma32(PAF(pw0), MLA_VF(4), o[1]), C0, 4); \
        GAPB(o[0] = mfma32(PAF(pw1), MLA_VF(1), o[0]), C0, 8); \
        GAPB(o[1] = mfma32(PAF(pw1), MLA_VF(5), o[1]), C0, 12); \
        GAPB(o[0] = mfma32(PAF(pw2), MLA_VF(2), o[0]), C1, 0); \
        GAPB(o[1] = mfma32(PAF(pw2), MLA_VF(6), o[1]), C1, 4); \
        GAPB(o[0] = mfma32(PAF(pw3), MLA_VF(3), o[0]), C1, 8); \
        GAPB(o[1] = mfma32(PAF(pw3), MLA_VF(7), o[1]), C1, 12); \
        if (resc) { asm volatile("s_waitcnt lgkmcnt(0)" ::: "memory"); \
            _Pragma("unroll") for (int r = 0; r < 16; ++r) { const float fr_ = wsf[crow(r, hi)]; o[0][r] *= fr_; o[1][r] *= fr_; } } \
    } while (0)
    int t = 1;
    for (; t + 1 < NT; t += 2) { STEP(pB0, pB1, pA0, pA1, t); STEP(pA0, pA1, pB0, pB1, t + 1); }
    STEP(pB0, pB1, pA0, pA1, t);
    { float sacc = 0.f;
#pragma unroll
      for (int r = 0; r < 16; ++r) sacc += pB0[r] + pB1[r];
      l_reg += sacc;
      ATT_WAITBAR();
      pv(o, vp0 + ((NT - 1) & 3) * VS, packp(pB0, 0), packp(pB0, 8), packp(pB1, 0), packp(pB1, 8)); }
#undef STEP
#undef GAPA
#undef GAPB
#undef PKW
#undef PAF
#undef KRD
#undef VRD
#undef SBAR
#undef PIN
#undef MLA_VF
#undef MLA_DMAK
#undef MLA_DMAV
#undef MLA_WAITBAR
#undef MLA_ISSUE
    l_reg = swapsum(l_reg);
    if (hi == 0) wsf[32 + r32] = l_reg;
    asm volatile("s_waitcnt lgkmcnt(0)" ::: "memory");
    float sc[16];
#pragma unroll
    for (int r = 0; r < 16; ++r) sc[r] = rcpf_(wsf[32 + crow(r, hi)]);
    const size_t row0 = rowbase + q0 + wid * 32;
    store_o(o, sc, OCAT + row0 * 1024 + h * 64, SSQO + row0 * 16 + h, shm + OST_OFF + wid * 4096, lane, r32, hi);
    ATT_WAITBAR();
}
#undef SGB

constexpr int KS_SB = 8192, SB_VOFF = 4 * KS_SB, SB_OST = SB_VOFF + 4 * VS;
__device__ __forceinline__ void sb_unit(int b, int h, int qb, const bf16_t* __restrict__ PROJ, bf16_t* OCAT, float* SSQO, ldsp shm, volatile LAS unsigned* FL) {
    const int tid = launder_v(threadIdx.x), lane = tid & 63, r32 = lane & 31, hi = lane >> 5; const int wid = __builtin_amdgcn_readfirstlane(tid >> 6);
    const size_t rowbase = (size_t)b * SEQ; const int q0 = qb * 256;
    const bf16_t* ksrc = PROJ + (rowbase + lane) * INP + 1024 + h * 64 + wid * 8;
    const bf16_t* vsrc = PROJ + (rowbase + 16 * (wid & 3) + (lane >> 2)) * INP + 1536 + h * 64 + (wid >> 2) * 32 + (lane & 3) * 8;
    const int tmax = 4 * qb + 3, tdw = 4 * qb + (wid >> 1);
#define SB_DMA(t, s) do { glds(ksrc + (size_t)(t) * 64 * INP, shm + (s) * KS_SB + wid * 1024); glds(vsrc + (size_t)(t) * 64 * INP, shm + SB_VOFF + (s) * VS + wid * 1024); } while (0)
    if (tid == 0) { FL[0] = 0u; FL[1] = 0u; FL[2] = 0u; }
#define SB_TILE(s) ((tmax - (s)) > 0 ? (tmax - (s)) : 0)
#define SB_WAITBAR() asm volatile("s_waitcnt vmcnt(4) lgkmcnt(0)\n\ts_barrier" ::: "memory")
    SB_DMA(SB_TILE(0), 0); SB_DMA(SB_TILE(1), 1); SB_DMA(SB_TILE(2), 2);
    bf16x8 qr[4];
    { const bf16_t* Qw = PROJ + (rowbase + q0 + wid * 32 + r32) * INP + 512 + h * 64 + hi * 8;
#pragma unroll
      for (int d0 = 0; d0 < 4; ++d0) qr[d0] = *(const GAS bf16x8*)(Qw + d0 * 16); }
    bf16x8 Ta, Tb, Ton;
#pragma unroll
    for (int j = 0; j < 8; ++j) { const int key = (j < 4) ? 4 * hi + j : 8 + 4 * hi + (j - 4); Ta[j] = (key > r32) ? (short)0x3F80 : (short)0; Tb[j] = (key + 16 > r32) ? (short)0x3F80 : (short)0; Ton[j] = (short)0x3F80; }
    const LAS unsigned char* vp0 = shm + SB_VOFF + ((lane >> 4) & 1) * 32 + (lane & 3) * 8 + (4 * hi + ((lane & 15) >> 2)) * 64;
    const int qabs = q0 + wid * 32 + r32;
    float Lc = 0.f; bool wfin = false; f32x16 o[2]; o[0] = f32x16{}; o[1] = f32x16{};
    int step = 0;
    for (int t = tmax; t >= 0; --t, ++step) {
        SB_WAITBAR();
        if (step > 0) { if (FL[(step - 1) % 3] == 0xFFu) break; }
        if (tid == 0) FL[(step + 1) % 3] = 0u;
        SB_DMA(SB_TILE(step + 3), (step + 3) & 3);
        if (t <= tdw && !wfin) {
            const LAS unsigned char* kb = shm + (step & 3) * KS_SB + hi * 1024 + r32 * 16;
            f32x16 z0 = f32x16{}, z1 = f32x16{};
#pragma unroll
            for (int d0 = 0; d0 < 4; ++d0) { const bf16x8 k0 = *(const LAS bf16x8*)(kb + d0 * 2048), k1 = *(const LAS bf16x8*)(kb + d0 * 2048 + 512);
                z0 = mfma32(k0, qr[d0], z0); z1 = mfma32(k1, qr[d0], z1); }
            const bool diag = (t == tdw); const int kb0 = t * 64 + 4 * hi;
            f32x16 l0, l1; float tot = 0.f;
#pragma unroll
            for (int r = 0; r < 16; ++r) { l0[r] = -lg2(1.0f + ex2(fminf(z0[r], 100.f))); l1[r] = -lg2(1.0f + ex2(fminf(z1[r], 100.f))); }
            if (diag) {
#pragma unroll
                for (int r = 0; r < 16; ++r) { const int kk = kb0 + (r & 3) + 8 * (r >> 2); if (kk >= qabs) l0[r] = 0.f; if (kk + 32 >= qabs) l1[r] = 0.f; } }
#pragma unroll
            for (int r = 0; r < 16; ++r) { tot += l0[r] + l1[r]; z0[r] += l0[r]; z1[r] += l1[r]; }
            u32x4 lh[4];
#pragma unroll
            for (int k = 0; k < 4; ++k)
#pragma unroll
                for (int j = 0; j < 4; ++j) { const float a = (k < 2) ? l0[(k & 1) * 8 + 2 * j] : l1[(k & 1) * 8 + 2 * j], c = (k < 2) ? l0[(k & 1) * 8 + 2 * j + 1] : l1[(k & 1) * 8 + 2 * j + 1];
                    lh[k][j] = cvt_pk_bf16(a, c); }
#define SB_B(x) __builtin_bit_cast(bf16x8, x)
            f32x16 x0, x1;
#pragma unroll
            for (int r = 0; r < 16; ++r) { x0[r] = Lc; x1[r] = Lc; }
            x0 = mfma32(Ta, SB_B(lh[0]), x0); x0 = mfma32(Tb, SB_B(lh[1]), x0); x0 = mfma32(Ton, SB_B(lh[2]), x0); x0 = mfma32(Ton, SB_B(lh[3]), x0);
            x1 = mfma32(Ta, SB_B(lh[2]), x1); x1 = mfma32(Tb, SB_B(lh[3]), x1);
#undef SB_B
#pragma unroll
            for (int r = 0; r < 16; ++r) { z0[r] = ex2(z0[r] + x0[r]); z1[r] = ex2(z1[r] + x1[r]); }
            if (diag) {
#pragma unroll
                for (int r = 0; r < 16; ++r) { const int kk = kb0 + (r & 3) + 8 * (r >> 2); if (kk >= qabs) z0[r] = 0.f; if (kk + 32 >= qabs) z1[r] = 0.f; } }
            pv(o, vp0 + (step & 3) * VS, packp(z0, 0), packp(z0, 8), packp(z1, 0), packp(z1, 8));
            Lc += swapsum(tot);
            wfin = __all(Lc <= SB_DONE) != 0;
        }
        if (t == 0) wfin = true;
        if (wfin && lane == 0) __hip_atomic_fetch_or((LAS unsigned*)&FL[step % 3], 1u << wid, __ATOMIC_RELAXED, __HIP_MEMORY_SCOPE_WORKGROUP);
    }
#undef SB_DMA
#undef SB_TILE
#undef SB_WAITBAR
    asm volatile("s_waitcnt vmcnt(0)" ::: "memory");
    float sc[16];
#pragma unroll
    for (int r = 0; r < 16; ++r) sc[r] = 1.0f;
    const size_t row0 = rowbase + q0 + wid * 32;
    store_o(o, sc, OCAT + row0 * 1024 + 512 + h * 64, SSQO + row0 * 16 + 8 + h, shm + SB_OST + wid * 4096, lane, r32, hi);
    ATT_WAITBAR();
}
__device__ __forceinline__ bool att_next(int i, int vcu, int G, int& bh, int& qb) { const int j = i * G + vcu; if (j >= 512) return false; const int jj = j & 255; bh = jj >> 4; qb = (j < 256) ? (jj & 15) : 31 - (jj & 15); return true; }
}

struct In {
    const float* x; const float* c; const int* pos; const float* w_ada; const float* b_ada; const float* g_mix; const float* g_ffn; const float* w_in;
    const float* g_q_lat; const float* w_uq; const float* g_kv_lat; const float* w_ukv; const float* g_grp_mla; const float* g_grp_sb; const float* w_out;
    const float* w_ff_gate; const float* w_ff_up; const float* w_ff_down; const float* w_router; const float* b_router; const float* w_ex_gate; const float* w_ex_up; const float* w_ex_down; const float* g_final;
};
struct Args { const void* in[24]; float* out; unsigned char* ws; int lo, hi; };

__device__ __forceinline__ void p0a_mod(const In& I, float* mod, ldsp lds) {
    const int tid = threadIdx.x; LAS float* ca = (LAS float*)lds; LAS f32x4* red = (LAS f32x4*)(lds + 8192);
    { const f32x4 v = gld4(I.c + tid * 4); f32x4 sv;
#pragma unroll
      for (int j = 0; j < 4; ++j) sv[j] = v[j] / (1.0f + __expf(-v[j]));
      *(LAS f32x4*)(ca + tid * 4) = sv; }
    __syncthreads();
    const int c4 = tid & 31, kq = tid >> 5;
    for (int it = blockIdx.x; it < NL * 48; it += gridDim.x) {
        const int l = it / 48, n = (it % 48) * 128 + c4 * 4; const float* w = I.w_ada + (size_t)l * 1024 * 6144 + (size_t)(kq * 64) * 6144 + n;
        f32x4 a0 = {0.f, 0.f, 0.f, 0.f}, a1 = {0.f, 0.f, 0.f, 0.f};
        f32x4 wv[8], wn[8];
#pragma unroll
        for (int j = 0; j < 8; ++j) wv[j] = gld4_nt(w + (size_t)j * 6144);
#pragma unroll 1
        for (int k0 = 0; k0 < 64; k0 += 8) {
            if (k0 + 8 < 64) {
#pragma unroll
                for (int j = 0; j < 8; ++j) wn[j] = gld4_nt(w + (size_t)(k0 + 8 + j) * 6144); }
#pragma unroll
            for (int j = 0; j < 8; ++j) { a0 += wv[j] * ca[kq * 64 + k0 + j]; a1 += wv[j] * ca[1024 + kq * 64 + k0 + j]; }
#pragma unroll
            for (int j = 0; j < 8; ++j) wv[j] = wn[j]; }
        red[(0 * 16 + kq) * 32 + c4] = a0; red[(1 * 16 + kq) * 32 + c4] = a1;
        __syncthreads();
        if (tid < 64) { const int b = tid >> 5; f32x4 s = {0.f, 0.f, 0.f, 0.f};
#pragma unroll
            for (int j = 0; j < 16; ++j) s += red[(b * 16 + j) * 32 + c4];
            gst4(mod + ((size_t)l * 2 + b) * 6144 + n, s + gld4(I.b_ada + (size_t)l * 6144 + n)); }
        __syncthreads();
    }
}

__device__ __forceinline__ void conv_wave(const float* src  , int srcN, int Ksrc, float nsc, const float* ks0, const float* ks1,
                                          int kb_lo, int kb_hi, unsigned char* dst, int ldk  , int n0, bool out8, const LAS float* shl, float* bias0, float* bias1, LAS float* scr, int lane) {
    const int nl = lane & 31, kh = lane >> 5; float b0 = 0.f, b1 = 0.f;
    for (int kb = kb_lo; kb < kb_hi; ++kb) { const int k0 = kb * 64;
        float w[32];
#pragma unroll
        for (int i = 0; i < 32; ++i) { const int k = k0 + 2 * i + kh; w[i] = (src != nullptr && k < Ksrc) ? __builtin_nontemporal_load((const GAS float*)(src + (size_t)k * srcN)) : 0.f; }
        if (ks0) {
#pragma unroll
            for (int i = 0; i < 32; ++i) { const int k = k0 + 2 * i + kh; if (k < Ksrc) w[i] *= (ks1 && k >= 512) ? ks1[k - 512] : ks0[k]; } }
#pragma unroll
        for (int i = 0; i < 32; ++i) { w[i] *= nsc; scr[(2 * i + kh) * 33 + nl] = w[i]; }
        if (shl) {
#pragma unroll
            for (int i = 0; i < 32; ++i) { const int k = k0 + 2 * i + kh; b0 += shl[k] * w[i]; b1 += shl[1024 + k] * w[i]; } }
        asm volatile("s_waitcnt lgkmcnt(0)" ::: "memory");
        if (!out8) { const int c = lane & 7;
#pragma unroll
            for (int j = 0; j < 4; ++j) { const int n = (lane >> 3) + 8 * j; const LAS float* s = scr + (8 * c) * 33 + n;
                u32x4 o; o.x = cvt_pk_bf16(s[0 * 33], s[1 * 33]); o.y = cvt_pk_bf16(s[2 * 33], s[3 * 33]); o.z = cvt_pk_bf16(s[4 * 33], s[5 * 33]); o.w = cvt_pk_bf16(s[6 * 33], s[7 * 33]);
                gst16((bf16_t*)dst + (size_t)(n0 + n) * ldk + k0 + 8 * c, o); } }
        else { const int c = lane & 3;
#pragma unroll
            for (int j = 0; j < 2; ++j) { const int n = (lane >> 2) + 16 * j; const LAS float* s = scr + (16 * c) * 33 + n;
                u32x4 o; o.x = cvt4_fp8(s[0 * 33] * W8_SCALE, s[1 * 33] * W8_SCALE, s[2 * 33] * W8_SCALE, s[3 * 33] * W8_SCALE); o.y = cvt4_fp8(s[4 * 33] * W8_SCALE, s[5 * 33] * W8_SCALE, s[6 * 33] * W8_SCALE, s[7 * 33] * W8_SCALE);
                o.z = cvt4_fp8(s[8 * 33] * W8_SCALE, s[9 * 33] * W8_SCALE, s[10 * 33] * W8_SCALE, s[11 * 33] * W8_SCALE); o.w = cvt4_fp8(s[12 * 33] * W8_SCALE, s[13 * 33] * W8_SCALE, s[14 * 33] * W8_SCALE, s[15 * 33] * W8_SCALE);
                gst16(dst + (size_t)(n0 + n) * ldk + k0 + 16 * c, o); } }
        asm volatile("s_waitcnt lgkmcnt(0)" ::: "memory");
    }
    if (shl) { b0 += __shfl_xor(b0, 32); b1 += __shfl_xor(b1, 32); if (lane < 32) { bias0[n0 + nl] = b0; bias1[n0 + nl] = b1; } }
}
constexpr int CI_EGU = 16 * 224, CI_ED = 16 * 32 * 4, CI_WGU = 2 * 160, CI_WD = 2 * 32 * 3, CI_WIN = 4 * 64, CI_WOUT = 4 * 32, CI_WUQ = 4 * 24, CI_WUKV = 4 * 32;
constexpr int N_CITEMS = CI_EGU + CI_ED + CI_WGU + CI_WD + CI_WIN + CI_WOUT + CI_WUQ + CI_WUKV;
constexpr int CI_SKIP = CI_EGU + CI_ED + CI_WGU + CI_WD;
__device__ __forceinline__ void conv_item(const In& I, unsigned char* ws, int it, const LAS float* shl_all  , LAS float* scr, int lane) {
    const int nl = lane & 31; int r = it;
    if (r < CI_EGU) { const int m = r / 224, st = r % 224, i = m >> 3, np = st * 32 + nl, tl = np >> 8, w = np & 255; const size_t so = (size_t)m * 1024 * DFE;
        const float* src = (w < 128 ? I.w_ex_gate : I.w_ex_up) + so + tl * 128 + (w & 127);
        conv_wave(src, DFE, 1024, 1.0f, nullptr, nullptr, 0, 16, ws + WS_EGU + (size_t)m * (2 * DFE) * 1024, 1024, st * 32, true, shl_all + ((2 * i + 1) * 2 + 1) * 2048,
                  (float*)(ws + WS_BEGU) + ((size_t)m * 2 + 0) * (2 * DFE), (float*)(ws + WS_BEGU) + ((size_t)m * 2 + 1) * (2 * DFE), scr, lane); return; }
    r -= CI_EGU;
    if (r < CI_ED) { const int m = r >> 7, st = (r & 127) >> 2, kp = r & 3;
        conv_wave(I.w_ex_down + (size_t)m * DFE * 1024 + st * 32 + nl, 1024, DFE, 1.0f, nullptr, nullptr, kp * 14, kp * 14 + 14, ws + WS_ED + (size_t)m * 1024 * DFE, DFE, st * 32, true, nullptr, nullptr, nullptr, scr, lane); return; }
    r -= CI_ED;
    if (r < CI_WGU) { const int i = r / 160, st = r % 160, np = st * 32 + nl, tl = np >> 8, w = np & 255;
        const float* src = (w < 128 ? I.w_ff_gate : I.w_ff_up) + (size_t)i * 1024 * DFF + tl * 128 + (w & 127);
        conv_wave(src, DFF, 1024, 1.0f, nullptr, nullptr, 0, 16, ws + WS_WGU + (size_t)i * (2 * DFF) * 1024 * 2, 1024, st * 32, false, shl_all + ((2 * i) * 2 + 1) * 2048,
                  (float*)(ws + WS_BGU) + ((size_t)i * 2 + 0) * (2 * DFF), (float*)(ws + WS_BGU) + ((size_t)i * 2 + 1) * (2 * DFF), scr, lane); return; }
    r -= CI_WGU;
    if (r < CI_WD) { const int i = r / 96, st = (r % 96) / 3, kp = r % 3; const int lo = kp == 0 ? 0 : (kp == 1 ? 14 : 27), hi = kp == 0 ? 14 : (kp == 1 ? 27 : 40);
        conv_wave(I.w_ff_down + (size_t)i * DFF * 1024 + st * 32 + nl, 1024, DFF, 1.0f, nullptr, nullptr, lo, hi, ws + WS_WD + (size_t)i * 1024 * DFF * 2, DFF, st * 32, false, nullptr, nullptr, nullptr, scr, lane); return; }
    r -= CI_WD;
    if (r < CI_WIN) { const int l = r >> 6, st = r & 63, np = st * 32 + nl; const float* W0 = I.w_in + (size_t)l * 1024 * INC; const float* src; float nsc = 1.0f;
        if (np < 384) src = W0 + np; else if (np < 416) src = W0 + 384 + ropedim(np - 384); else if (np < 512) src = nullptr; else if (np < 1024) { src = W0 + 416 + (np - 512); nsc = C2S; } else src = W0 + 928 + (np - 1024);
        conv_wave(src, INC, 1024, nsc, nullptr, nullptr, 0, 16, ws + WS_WIN + (size_t)l * INP * 1024 * 2, 1024, st * 32, false, shl_all + (l * 2 + 0) * 2048,
                  (float*)(ws + WS_BIN) + ((size_t)l * 2 + 0) * INP, (float*)(ws + WS_BIN) + ((size_t)l * 2 + 1) * INP, scr, lane); return; }
    r -= CI_WIN;
    if (r < CI_WOUT) { const int l = r >> 5, st = r & 31;
        conv_wave(I.w_out + (size_t)l * 1024 * 1024 + st * 32 + nl, 1024, 1024, 1.0f, I.g_grp_mla + l * 512, I.g_grp_sb + l * 512, 0, 16, ws + WS_WOUT + (size_t)l * 1024 * 1024 * 2, 1024, st * 32, false, nullptr, nullptr, nullptr, scr, lane); return; }
    r -= CI_WOUT;
    if (r < CI_WUQ) { const int l = r / 24, st = r % 24, np = st * 32 + nl, hh = np / 96, w = np % 96;
        conv_wave(I.w_uq + (size_t)l * 256 * QW + hh * 96 + (w < 64 ? w : 64 + ropedim(w - 64)), QW, 256, C2Q, I.g_q_lat + l * 256, nullptr, 0, 4, ws + WS_WUQ + (size_t)l * QW * 256 * 2, 256, st * 32, false, nullptr, nullptr, nullptr, scr, lane); return; }
    r -= CI_WUQ;
    { const int l = r >> 5, st = r & 31;
      conv_wave(I.w_ukv + (size_t)l * 128 * KVW + st * 32 + nl, KVW, 128, 1.0f, I.g_kv_lat + l * 128, nullptr, 0, 2, ws + WS_WUKV + (size_t)l * KVW * 128 * 2, 128, st * 32, false, nullptr, nullptr, nullptr, scr, lane); }
}
template <bool OUT8> __device__ __forceinline__ void conv_wide(const float* W0, const float* W1, int srcN, const float* ks0, const float* ks1, int kb_lo, int kb_hi,
                                                               unsigned char* dst, int ldk  , int n0, const LAS float* shl, float* bias0, float* bias1, ldsp lds) {
    const int tid = threadIdx.x, lane = tid & 63, wid = __builtin_amdgcn_readfirstlane(tid >> 6);
    constexpr int RS = OUT8 ? 72 : 136;
    LAS unsigned char* tile = lds; LAS float* red = (LAS float*)(lds + 256 * 136);
    const float* src = (W1 != nullptr && lane >= 32) ? W1 + 4 * (lane - 32) : W0 + 4 * lane;
    f32x4 v[8], vn[8]; f32x4 b0 = {0.f, 0.f, 0.f, 0.f}, b1 = {0.f, 0.f, 0.f, 0.f};
#pragma unroll
    for (int j = 0; j < 8; ++j) v[j] = gld4_nt(src + (size_t)(kb_lo * 64 + 8 * wid + j) * srcN);
    for (int kb = kb_lo; kb < kb_hi; ++kb) { const int k0 = kb * 64 + 8 * wid;
        if (kb + 1 < kb_hi) {
#pragma unroll
            for (int j = 0; j < 8; ++j) vn[j] = gld4_nt(src + (size_t)(k0 + 64 + j) * srcN); }
        if (ks0) {
#pragma unroll
            for (int j = 0; j < 8; ++j) { const int k = k0 + j; v[j] = v[j] * ((ks1 && k >= 512) ? ks1[k - 512] : ks0[k]); } }
        if (shl) {
#pragma unroll
            for (int j = 0; j < 8; ++j) { b0 += v[j] * shl[k0 + j]; b1 += v[j] * shl[1024 + k0 + j]; } }
#pragma unroll
        for (int c = 0; c < 4; ++c) { LAS unsigned char* tp = tile + (4 * lane + c) * RS;
            if constexpr (OUT8) { u32x2 w; w.x = cvt4_fp8(v[0][c] * W8_SCALE, v[1][c] * W8_SCALE, v[2][c] * W8_SCALE, v[3][c] * W8_SCALE); w.y = cvt4_fp8(v[4][c] * W8_SCALE, v[5][c] * W8_SCALE, v[6][c] * W8_SCALE, v[7][c] * W8_SCALE);
                *(LAS u32x2*)(tp + 8 * wid) = w; }
            else { u32x2 w0, w1; w0.x = cvt_pk_bf16(v[0][c], v[1][c]); w0.y = cvt_pk_bf16(v[2][c], v[3][c]); w1.x = cvt_pk_bf16(v[4][c], v[5][c]); w1.y = cvt_pk_bf16(v[6][c], v[7][c]);
                *(LAS u32x2*)(tp + 16 * wid) = w0; *(LAS u32x2*)(tp + 16 * wid + 8) = w1; } }
        __syncthreads();
        { const int row = tid >> 1, hf = tid & 1;
          if constexpr (OUT8) { const LAS unsigned char* tp = tile + row * RS + hf * 32; unsigned char* dp = dst + (size_t)(n0 + row) * ldk + kb * 64 + hf * 32;
#pragma unroll
              for (int q = 0; q < 2; ++q) { const u32x2 lo = *(const LAS u32x2*)(tp + q * 16), hi2 = *(const LAS u32x2*)(tp + q * 16 + 8); gst16(dp + q * 16, (u32x4){lo.x, lo.y, hi2.x, hi2.y}); } }
          else { const LAS unsigned char* tp = tile + row * RS + hf * 64; bf16_t* dp = (bf16_t*)dst + (size_t)(n0 + row) * ldk + kb * 64 + hf * 32;
#pragma unroll
              for (int q = 0; q < 4; ++q) { const u32x2 lo = *(const LAS u32x2*)(tp + q * 16), hi2 = *(const LAS u32x2*)(tp + q * 16 + 8); gst16(dp + q * 8, (u32x4){lo.x, lo.y, hi2.x, hi2.y}); } } }
        __syncthreads();
#pragma unroll
        for (int j = 0; j < 8; ++j) v[j] = vn[j];
    }
    if (shl) {
#pragma unroll
        for (int c = 0; c < 4; ++c) { red[(0 * 8 + wid) * 256 + 4 * lane + c] = b0[c]; red[(1 * 8 + wid) * 256 + 4 * lane + c] = b1[c]; }
        __syncthreads();
        { const int b = tid >> 8, n = tid & 255; float a = 0.f;
#pragma unroll
          for (int j = 0; j < 8; ++j) a += red[(b * 8 + j) * 256 + n];
          atomicAdd((b ? bias1 : bias0) + n0 + n, a); }
        __syncthreads();
    }
}
constexpr int WI_EGU = 16 * 28 * 2, WI_ED = 16 * 4 * 7, WI_WGU = 2 * 20 * 2, WI_WD = 2 * 4 * 5, WI_WOUT = 4 * 4 * 2, N_WITEMS = WI_EGU + WI_ED + WI_WGU + WI_WD + WI_WOUT;
__device__ __forceinline__ void wide_item(const In& I, unsigned char* ws, int it, const LAS float* shl_all, ldsp lds) {
    int r = it;
    if (r < WI_EGU) { const int m = r / 56, rem = r % 56, st = rem >> 1, hf = rem & 1, i = m >> 3; const size_t so = (size_t)m * 1024 * DFE + st * 128;
        conv_wide<true>(I.w_ex_gate + so, I.w_ex_up + so, DFE, nullptr, nullptr, hf * 8, hf * 8 + 8, ws + WS_EGU + (size_t)m * (2 * DFE) * 1024, 1024, st * 256, shl_all + ((2 * i + 1) * 2 + 1) * 2048,
                        (float*)(ws + WS_BEGU) + ((size_t)m * 2 + 0) * (2 * DFE), (float*)(ws + WS_BEGU) + ((size_t)m * 2 + 1) * (2 * DFE), lds); return; }
    r -= WI_EGU;
    if (r < WI_ED) { const int m = r / 28, rem = r % 28, st = rem / 7, kp = rem % 7;
        conv_wide<true>(I.w_ex_down + (size_t)m * DFE * 1024 + st * 256, nullptr, 1024, nullptr, nullptr, kp * 8, kp * 8 + 8, ws + WS_ED + (size_t)m * 1024 * DFE, DFE, st * 256, nullptr, nullptr, nullptr, lds); return; }
    r -= WI_ED;
    if (r < WI_WGU) { const int i = r / 40, rem = r % 40, st = rem >> 1, hf = rem & 1; const size_t so = (size_t)i * 1024 * DFF + st * 128;
        conv_wide<false>(I.w_ff_gate + so, I.w_ff_up + so, DFF, nullptr, nullptr, hf * 8, hf * 8 + 8, ws + WS_WGU + (size_t)i * (2 * DFF) * 1024 * 2, 1024, st * 256, shl_all + ((2 * i) * 2 + 1) * 2048,
                         (float*)(ws + WS_BGU) + ((size_t)i * 2 + 0) * (2 * DFF), (float*)(ws + WS_BGU) + ((size_t)i * 2 + 1) * (2 * DFF), lds); return; }
    r -= WI_WGU;
    if (r < WI_WD) { const int i = r / 20, rem = r % 20, st = rem / 5, kp = rem % 5;
        conv_wide<false>(I.w_ff_down + (size_t)i * DFF * 1024 + st * 256, nullptr, 1024, nullptr, nullptr, kp * 8, kp * 8 + 8, ws + WS_WD + (size_t)i * 1024 * DFF * 2, DFF, st * 256, nullptr, nullptr, nullptr, lds); return; }
    r -= WI_WD;
    { const int l = r >> 3, rem = r & 7, st = rem >> 1, hf = rem & 1;
      conv_wide<false>(I.w_out + (size_t)l * 1024 * 1024 + st * 256, nullptr, 1024, I.g_grp_mla + l * 512, I.g_grp_sb + l * 512, hf * 8, hf * 8 + 8, ws + WS_WOUT + (size_t)l * 1024 * 1024 * 2, 1024, st * 256, nullptr, nullptr, nullptr, lds); }
}
__device__ __forceinline__ void sincos_red(float ang, float& sn, float& cs) {
    const double a = (double)ang; const double kq = __builtin_rint(a * 0.63661977236758134308); const int q = (int)kq & 3;
    const float r = (float)(a - kq * 1.57079632679489661923); const float r2 = r * r;
    const float s = r + r * r2 * (-1.6666667163e-1f + r2 * (8.3333337680e-3f + r2 * (-1.9841270114e-4f + r2 * 2.7557314297e-6f)));
    const float c = 1.0f + r2 * (-0.5f + r2 * (4.1666667908e-2f + r2 * (-1.3888889225e-3f + r2 * (2.4801587642e-5f + r2 * -2.7557314297e-7f))));
    sn = (q == 0) ? s : (q == 1) ? c : (q == 2) ? -s : -c; cs = (q == 0) ? c : (q == 1) ? -s : (q == 2) ? -c : s;
}
constexpr int NW_A0 = MT / 16, NW_GS = NL * 4 * 2 * 1024 / 64;
__device__ __forceinline__ void p0b_wave(const In& I, unsigned char* ws, int it, int lane) {
    const float* mod = (const float*)(ws + WS_MOD);
    if (it < NW_A0) {
        const int b = (it * 16) >> 13; const float* sc = mod + (size_t)b * 6144 + 1024;
        f32x4 gm[4];
#pragma unroll
        for (int j = 0; j < 4; ++j) { const int c0 = j * 256 + lane * 4; gm[j] = gld4(I.g_mix + c0) * (gld4(sc + c0) + 1.0f); }
#pragma unroll 1
        for (int q = 0; q < 4; ++q) { const int row0 = it * 16 + q * 4;
            f32x4 xv[4][4];
#pragma unroll
            for (int r = 0; r < 4; ++r)
#pragma unroll
                for (int j = 0; j < 4; ++j) xv[r][j] = gld4(I.x + (size_t)(row0 + r) * 1024 + j * 256 + lane * 4);
#pragma unroll
            for (int r = 0; r < 4; ++r) { const int row = row0 + r; bf16_t* ar = (bf16_t*)(ws + WS_AMIX) + (size_t)row * 1024; float ss = 0.f;
#pragma unroll
                for (int j = 0; j < 4; ++j) { const int c0 = j * 256 + lane * 4; ss += prob::dot4(xv[r][j]);
                    { u32x2 wx; wx.x = cvt_pk_bf16(xv[r][j][0], xv[r][j][1]); wx.y = cvt_pk_bf16(xv[r][j][2], xv[r][j][3]); gst8((bf16_t*)(ws + WS_X) + (size_t)row * 1024 + c0, wx); }
                    const f32x4 a = xv[r][j] * gm[j]; u32x2 w; w.x = cvt_pk_bf16(a[0], a[1]); w.y = cvt_pk_bf16(a[2], a[3]); gst8(ar + c0, w); }
                ss = wave_sum(ss);
                if (lane < 16) ((float*)(ws + WS_SSQX))[(size_t)row * 16 + lane] = lane == 0 ? ss : 0.f;
                if (lane < 16) { const float invf = exp2f(-(float)lane * (13.287712379549449f / 16.0f)); const float ang = (float)I.pos[row] * invf; float sn, cs; sincos_red(ang, sn, cs);
                    ((float*)(ws + WS_COS))[(size_t)row * 16 + lane] = cs; ((float*)(ws + WS_SIN))[(size_t)row * 16 + lane] = sn; } } }
    } else {
        const int idx = (it - NW_A0) * 64 + lane; const int k = idx & 1023, b = (idx >> 10) & 1, kind = (idx >> 11) & 3, l = idx >> 13; const float* mb = mod + ((size_t)l * 2 + b) * 6144;
        float v; if (kind == 0) v = I.g_mix[l * 1024 + k] * (1.0f + mb[1024 + k]); else if (kind == 1) v = mb[2048 + k]; else if (kind == 2) v = I.g_ffn[l * 1024 + k] * (1.0f + mb[4096 + k]); else v = mb[5120 + k];
        ((float*)(ws + WS_GS))[idx] = v;
    }
}
__device__ __forceinline__ const float* gs_ptr(const unsigned char* ws, int l, int kind) { return (const float*)(ws + WS_GS) + ((size_t)l * 4 + kind) * 2048; }

__device__ __forceinline__ void router_phase(const In& I, unsigned char* ws, int l, ldsp lds) {
    const int tid = launder_v(threadIdx.x), lane = tid & 63, wid = __builtin_amdgcn_readfirstlane(tid >> 6), i = l >> 1;
    LAS float* wr = (LAS float*)lds;
    LAS float* gs = (LAS float*)(lds + 32768);
    LAS float* br = (LAS float*)(lds + 40960);
    LAS int* lcnt = (LAS int*)(lds + 41216);
    LAS int* gbase = (LAS int*)(lds + 41280);
    LAS int* rec = (LAS int*)(lds + 41472);
    const float* gsf = gs_ptr(ws, l, 2); const float* mod = (const float*)(ws + WS_MOD);
    {
      f32x4 t[4], s0[4], s1[4]; const float* sh0 = mod + ((size_t)l * 2 + 0) * 6144 + 3072; const float* sh1 = sh0 + 6144;
#pragma unroll
      for (int j = 0; j < 4; ++j) t[j] = gld4(I.w_router + (size_t)i * 8192 + (size_t)(tid + 512 * j) * 4);
      const f32x4 g4 = gld4(gsf + tid * 4);
#pragma unroll
      for (int j = 0; j < 4; ++j) { s0[j] = gld4(sh0 + lane * 4 + 256 * j); s1[j] = gld4(sh1 + lane * 4 + 256 * j); }
      const float brb = I.b_router[i * 8 + wid];
#pragma unroll
      for (int j = 0; j < 4; ++j) *(LAS f32x4*)(wr + (tid + 512 * j) * 4) = t[j];
      *(LAS f32x4*)(gs + tid * 4) = g4;
      if (tid < 8) lcnt[tid] = 0;
      __syncthreads();
      float a0 = 0.f, a1 = 0.f;
#pragma unroll
      for (int j = 0; j < 4; ++j)
#pragma unroll
          for (int c = 0; c < 4; ++c) { const float w = wr[(lane * 4 + 256 * j + c) * 8 + wid]; a0 += s0[j][c] * w; a1 += s1[j][c] * w; }
      a0 = wave_sum(a0); a1 = wave_sum(a1);
      if (lane == 0) { br[wid] = a0 + brb; br[8 + wid] = a1 + brb; } }
    __syncthreads();
    const bf16_t* X = (const bf16_t*)(ws + WS_X); float* rtok = (float*)(ws + WS_RTOK); int* rowtok = (int*)(ws + WS_ROWTOK); float* roww = (float*)(ws + WS_ROWW); float* rowr = (float*)(ws + WS_ROWR);
    unsigned* cnt = (unsigned*)(ws + WS_CTL) + CW_CNT + i * 8 * 64;
    for (int base = blockIdx.x * 64; base < MT; base += gridDim.x * 64) {
        u32x2 xall[8][4];
#pragma unroll
        for (int j = 0; j < 8; ++j)
#pragma unroll
            for (int q = 0; q < 4; ++q) xall[j][q] = *(const GAS u32x2*)(X + (size_t)(base + wid * 8 + j) * 1024 + q * 256 + lane * 4);
#pragma unroll
        for (int j = 0; j < 8; ++j) {
            const int tk = base + wid * 8 + j, b = tk >> 13;
            float ss = 0.f, d[8];
#pragma unroll
            for (int e = 0; e < 8; ++e) d[e] = 0.f;
#pragma unroll
            for (int q = 0; q < 4; ++q) { const int c0 = q * 256 + lane * 4; const u32x2 xr = xall[j][q]; const f32x4 xv = (f32x4){bf_lo(xr.x), bf_hi(xr.x), bf_lo(xr.y), bf_hi(xr.y)}; ss += prob::dot4(xv);
#pragma unroll
                for (int jj = 0; jj < 4; ++jj) { const float a = xv[jj] * gs[b * 1024 + c0 + jj]; const f32x4 w0 = *(const LAS f32x4*)(wr + (c0 + jj) * 8), w1 = *(const LAS f32x4*)(wr + (c0 + jj) * 8 + 4);
                    d[0] += a * w0[0]; d[1] += a * w0[1]; d[2] += a * w0[2]; d[3] += a * w0[3]; d[4] += a * w1[0]; d[5] += a * w1[1]; d[6] += a * w1[2]; d[7] += a * w1[3]; } }
            ss = wave_sum(ss); const float r = rsq_(ss * (1.0f / 1024.0f) + EPS);
            float lg[8];
#pragma unroll
            for (int e = 0; e < 8; ++e) lg[e] = wave_sum(d[e]) * r + br[b * 8 + e];
            int e1 = 0; float v1 = lg[0];
#pragma unroll
            for (int e = 1; e < 8; ++e) if (lg[e] > v1) { v1 = lg[e]; e1 = e; }
            int e2 = -1; float v2 = -INFINITY;
#pragma unroll
            for (int e = 0; e < 8; ++e) if (e != e1 && lg[e] > v2) { v2 = lg[e]; e2 = e; }
            const float w2 = 1.0f / (1.0f + __expf(v1 - v2)), w1 = 1.0f - w2;
            if (lane == 0) { const int li1 = __hip_atomic_fetch_add(lcnt + e1, 1, __ATOMIC_RELAXED, __HIP_MEMORY_SCOPE_WORKGROUP), li2 = __hip_atomic_fetch_add(lcnt + e2, 1, __ATOMIC_RELAXED, __HIP_MEMORY_SCOPE_WORKGROUP);
                LAS int* rc = rec + (wid * 8 + j) * 8; rc[0] = e1; rc[1] = e2; rc[2] = li1; rc[3] = li2; rc[4] = __float_as_int(w1); rc[5] = __float_as_int(w2); rc[6] = __float_as_int(r); rtok[tk] = r; }
        }
        __syncthreads();
        if (tid < 8) { gbase[tid] = (int)__hip_atomic_fetch_add(cnt + tid * 64, (unsigned)lcnt[tid], __ATOMIC_RELAXED, __HIP_MEMORY_SCOPE_AGENT); }
        __syncthreads();
        if (tid < 128) { const int t = tid >> 1, sl = tid & 1; const LAS int* rc = rec + t * 8; const int e = rc[sl], p = gbase[e] + rc[2 + sl];
            rowtok[(size_t)e * MT + p] = (base + t) * 2 + sl; roww[(size_t)e * MT + p] = __int_as_float(rc[4 + sl]); rowr[(size_t)e * MT + p] = __int_as_float(rc[6]); }
        __syncthreads();
        if (tid < 8) lcnt[tid] = 0;
        __syncthreads();
    }
}
__device__ __forceinline__ void combine_phase(const In& I, unsigned char* ws, float* out, int l) {
    const int tid = launder_v(threadIdx.x), lane = tid & 63, wid = tid >> 6; const bool lastl = (l == NL - 1);
    bf16_t* X = (bf16_t*)(ws + WS_X); const bf16_t* Y = (const bf16_t*)(ws + WS_Y); const float* gate = gs_ptr(ws, l, 3); const float* gsn = gs_ptr(ws, lastl ? l : l + 1, 0);
    for (int row8 = (blockIdx.x * 8 + wid) * 8; row8 < MT; row8 += gridDim.x * 64) {
      f32x4 gq[4], nq[4];
#pragma unroll
      for (int q = 0; q < 4; ++q) { const int c0 = q * 256 + lane * 4, bq = row8 >> 13; gq[q] = gld4(gate + bq * 1024 + c0); nq[q] = lastl ? gld4(I.g_final + c0) : gld4(gsn + bq * 1024 + c0); }
#pragma unroll
      for (int hb = 0; hb < 2; ++hb) { const int row0 = row8 + hb * 4;
        u32x2 xv[4][4]; u32x2 y0[4][4], y1[4][4];
#pragma unroll
        for (int r = 0; r < 4; ++r)
#pragma unroll
            for (int q = 0; q < 4; ++q) { const int c0 = q * 256 + lane * 4; const size_t row = (size_t)(row0 + r);
                xv[r][q] = *(const GAS u32x2*)(X + row * 1024 + c0); y0[r][q] = *(const GAS u32x2*)(Y + (2 * row) * 1024 + c0); y1[r][q] = *(const GAS u32x2*)(Y + (2 * row + 1) * 1024 + c0); }
#pragma unroll
        for (int r = 0; r < 4; ++r) { const int row = row0 + r; f32x4 xn[4]; float ss = 0.f;
#pragma unroll
            for (int q = 0; q < 4; ++q) { const f32x4 g = gq[q]; const u32x2 a0 = y0[r][q], a1 = y1[r][q];
                const f32x4 ys = (f32x4){bf_lo(a0.x) + bf_lo(a1.x), bf_hi(a0.x) + bf_hi(a1.x), bf_lo(a0.y) + bf_lo(a1.y), bf_hi(a0.y) + bf_hi(a1.y)};
                const u32x2 xr = xv[r][q]; xn[q] = (f32x4){bf_lo(xr.x), bf_hi(xr.x), bf_lo(xr.y), bf_hi(xr.y)} + g * ys; ss += prob::dot4(xn[q]); }
            ss = wave_sum(ss);
            if (lastl) { const float rr = rsq_(ss * (1.0f / 1024.0f) + EPS);
#pragma unroll
                for (int q = 0; q < 4; ++q) { const int c0 = q * 256 + lane * 4; gst4(out + (size_t)row * 1024 + c0, xn[q] * rr * nq[q]); }
            } else {
#pragma unroll
                for (int q = 0; q < 4; ++q) { const int c0 = q * 256 + lane * 4; { u32x2 wx; wx.x = cvt_pk_bf16(xn[q][0], xn[q][1]); wx.y = cvt_pk_bf16(xn[q][2], xn[q][3]); gst8(X + (size_t)row * 1024 + c0, wx); } const f32x4 a = xn[q] * nq[q];
                    u32x2 w; w.x = cvt_pk_bf16(a[0], a[1]); w.y = cvt_pk_bf16(a[2], a[3]); gst8((bf16_t*)(ws + WS_AMIX) + (size_t)row * 1024 + c0, w); }
                if (lane < 16) ((float*)(ws + WS_SSQX))[(size_t)row * 16 + lane] = lane == 0 ? ss : 0.f;
            } } }
    }
}

constexpr int N_PHASE = 2 + 8 * NL;
__global__ void __launch_bounds__(512, 2) fwd_kernel(Args args) {
    extern __shared__ __attribute__((aligned(16))) unsigned char lds_raw[];
    const ldsp lds = (ldsp)lds_raw; const ldsp tab = lds + TAB_OFF;
    volatile LAS unsigned* MISC = (volatile LAS unsigned*)(lds + MISC_OFF);
    const int tid = threadIdx.x; const int G = gridDim.x, bx = blockIdx.x; const int vcu = (G % 8 == 0) ? (bx % 8) * (G / 8) + bx / 8 : bx;
    unsigned char* const ws0 = args.ws;
#define LOAD_IN(I) In I; I.x = (const float*)args.in[0]; I.c = (const float*)args.in[1]; I.pos = (const int*)args.in[2]; I.w_ada = (const float*)args.in[3]; I.b_ada = (const float*)args.in[4]; I.g_mix = (const float*)args.in[5]; \
    I.g_ffn = (const float*)args.in[6]; I.w_in = (const float*)args.in[7]; I.g_q_lat = (const float*)args.in[8]; I.w_uq = (const float*)args.in[9]; I.g_kv_lat = (const float*)args.in[10]; I.w_ukv = (const float*)args.in[11]; \
    I.g_grp_mla = (const float*)args.in[12]; I.g_grp_sb = (const float*)args.in[13]; I.w_out = (const float*)args.in[14]; I.w_ff_gate = (const float*)args.in[15]; I.w_ff_up = (const float*)args.in[16]; I.w_ff_down = (const float*)args.in[17]; \
    I.w_router = (const float*)args.in[18]; I.b_router = (const float*)args.in[19]; I.w_ex_gate = (const float*)args.in[20]; I.w_ex_up = (const float*)args.in[21]; I.w_ex_down = (const float*)args.in[22]; I.g_final = (const float*)args.in[23]
#define WSP(name) unsigned char* name = ws0; asm volatile("" : "+s"(name))
    for (int u = tid; u < 256; u += 512) MISC[u] = 0u;
    __syncthreads();
    const XcdBarrier bar = xcd_barrier_post((unsigned*)(ws0 + WS_CTL) + CW_BAR, MISC + 8);
    const int lo = args.lo, hi = args.hi;
#ifndef PHMASK
#define PHMASK 0xFFFFFFFFu
#endif
#define PHON(j) ((PHMASK >> (j)) & 1u)
#ifndef REP_PH
#define REP_PH -1
#define REP_N 1
#endif
#ifndef REP_DRY
#define REP_DRY 0
#endif
#define REPS(j) for (int rep_ = 0; rep_ < ((REP_PH) == (j) ? (REP_N) : 1); ++rep_)
#define IN(k) (lo <= (k) && (k) < hi)
#define SEAM(k) do { if (lo < (k) && (k) < hi) xcd_barrier(bar); } while (0)

    REPS(0) {
    if (rep_ > 0) xcd_barrier(bar);
    if (PHON(0) && IN(0)) { LOAD_IN(I); p0a_mod(I, (float*)(ws0 + WS_MOD), lds);
        { constexpr int NZ = (int)((WS_SSQX - WS_BGU) / 16); const int zb = G > NL * 48 ? G - NL * 48 : G, z0 = G > NL * 48 ? bx - NL * 48 : bx;
          if (z0 >= 0) for (int i = z0 * 512 + tid; i < NZ; i += zb * 512) gst4((float*)(ws0 + WS_BGU) + (size_t)i * 4, f32x4{0.f, 0.f, 0.f, 0.f}); } }
    SEAM(1);
    if (PHON(1) && IN(1)) { LOAD_IN(I);
        {
          LAS float* shl = (LAS float*)(lds + 8 * 8448); const float* mod = (const float*)(ws0 + WS_MOD);
          { f32x4 t[8];
#pragma unroll
            for (int j = 0; j < 8; ++j) { const int i = (tid + 512 * j) * 4; const int k = i & 1023, b = (i >> 10) & 1, kind = (i >> 11) & 1, l = i >> 12; t[j] = gld4(mod + ((size_t)l * 2 + b) * 6144 + kind * 3072 + k); }
#pragma unroll
            for (int j = 0; j < 8; ++j) *(LAS f32x4*)(shl + (tid + 512 * j) * 4) = t[j]; }
          __syncthreads();
          const int lane = tid & 63, wid = __builtin_amdgcn_readfirstlane(tid >> 6); LAS float* scr = (LAS float*)(lds + wid * 8448);
          unsigned* qh = (unsigned*)(ws0 + WS_CTL) + CW_QUEUE; volatile LAS int* qslot = (volatile LAS int*)(lds + MISC_OFF + 512);
          for (;;) {
              if (tid == 0) *qslot = (int)__hip_atomic_fetch_add(qh, 1u, __ATOMIC_RELAXED, __HIP_MEMORY_SCOPE_AGENT);
              __syncthreads(); const int it = *qslot; __syncthreads();
              if (it >= N_WITEMS) break; wide_item(I, ws0, it, shl, lds); }
          for (;;) { int it = 0; if (lane == 0) it = (int)__hip_atomic_fetch_add(qh + 64, 1u, __ATOMIC_RELAXED, __HIP_MEMORY_SCOPE_AGENT); it = __builtin_amdgcn_readfirstlane(it);
              if (it >= CI_WIN + CI_WUQ + CI_WUKV + NW_A0 + NW_GS) break;
              if (it >= CI_WIN + CI_WUQ + CI_WUKV) { p0b_wave(I, ws0, it - (CI_WIN + CI_WUQ + CI_WUKV), lane); continue; }
              int ci = it < CI_WIN ? CI_SKIP + it : CI_SKIP + CI_WOUT + it; conv_item(I, ws0, ci, shl, scr, lane); }
          __syncthreads(); } }
    }

#pragma nounroll
    for (int l = 0; l < NL; ++l) {
        const int pb = 2 + 8 * l;
        SEAM(pb + 0);
        REPS(2) if (PHON(2) && IN(pb + 0)) { WSP(ws); prob::PIn P; P.A = (const char*)(ws + WS_AMIX); P.lda = 1024; P.K = 1024; P.Bt = (const char*)((bf16_t*)(ws + WS_WIN) + (size_t)l * INP * 1024); P.ord.init(64, 8, G, launder_s(bx));
            P.ws = ws; P.l = l;
            P.dry = rep_ > 0 ? REP_DRY : 0; pg8::gemm_phase<prob::PIn, true>(lds, tab, P); }
        SEAM(pb + 1);
        if (PHON(3) && IN(pb + 1)) {
            REPS(12) if (PHON(12)) { WSP(ws); prob::PQ P; P.A = (const char*)(ws + WS_PROJ); P.lda = INP; P.K = 256; P.Bt = (const char*)((bf16_t*)(ws + WS_WUQ) + (size_t)l * QW * 256); P.ord.init(64, 3, G, launder_s(bx));
              P.ws = ws;
              P.dry = rep_ > 0 ? REP_DRY : 0; pg8::gemm_phase<prob::PQ, true>(lds, tab, P); }
            REPS(12) if (PHON(13)) { WSP(ws); prob::PKV P; P.A = (const char*)(ws + WS_PROJ + 512); P.lda = INP; P.K = launder_s(128)  ; P.Bt = (const char*)((bf16_t*)(ws + WS_WUKV) + (size_t)l * KVW * 128); P.ord.init(64, 4, G, launder_s(bx));
              P.ws = ws;
              P.dry = rep_ > 0 ? REP_DRY : 0; pg8::gemm_phase<prob::PKV, true>(lds, tab, P); }
            REPS(14) if (PHON(14)) { WSP(ws); int bh, qb; const int vc = launder_s(vcu); for (int i = 0; att::att_next(i, vc, G, bh, qb); ++i) att::sb_unit(bh >> 3, bh & 7, qb, (const bf16_t*)(ws + WS_PROJ), (bf16_t*)(ws + WS_OCAT), (float*)(ws + WS_SSQO), lds, MISC + 16); }
        }
        SEAM(pb + 2);
        REPS(4) if (PHON(4) && IN(pb + 2)) { WSP(ws); int bh, qb; const int vc = launder_s(vcu); for (int i = 0; att::att_next(i, vc, G, bh, qb); ++i)
            att::mla_unit(bh >> 3, bh & 7, qb, (const bf16_t*)(ws + WS_QMLA), (const bf16_t*)(ws + WS_KV), (const bf16_t*)(ws + WS_PROJ), (bf16_t*)(ws + WS_OCAT), (float*)(ws + WS_SSQO), lds); }
        SEAM(pb + 3);
        REPS(5) if (PHON(5) && IN(pb + 3)) { WSP(ws); prob::POut P; P.A = (const char*)(ws + WS_OCAT); P.lda = 1024; P.K = 1024; P.Bt = (const char*)((bf16_t*)(ws + WS_WOUT) + (size_t)l * 1024 * 1024); P.ord.init(64, 4, G, launder_s(bx));
            P.ws = ws; P.l = l; P.xin0 = (const float*)args.in[0];
            P.dry = rep_ > 0 ? REP_DRY : 0; pg8::gemm_phase<prob::POut, true>(lds, tab, P); }
        if ((l & 1) == 0) {
            const int i = l >> 1;
            SEAM(pb + 4);
            REPS(6) if (PHON(6) && IN(pb + 4)) { WSP(ws); prob::PGU P; P.A = (const char*)(ws + WS_AFFN); P.lda = 1024; P.K = 1024; P.Bt = (const char*)((bf16_t*)(ws + WS_WGU) + (size_t)i * (2 * DFF) * 1024); P.ord.init(64, 20, G, launder_s(bx));
                P.ws = ws; P.i = i;
                P.dry = rep_ > 0 ? REP_DRY : 0; pg8::gemm_phase<prob::PGU, true>(lds, tab, P); }
            SEAM(pb + 5);
            REPS(7) if (PHON(7) && IN(pb + 5)) { WSP(ws); prob::PDown P; P.A = (const char*)(ws + WS_ACT); P.lda = DFF; P.K = DFF; P.Bt = (const char*)((bf16_t*)(ws + WS_WD) + (size_t)i * 1024 * DFF); P.ord.init(64, 4, G, launder_s(bx));
                P.ws = ws; P.l = l;
                P.dry = rep_ > 0 ? REP_DRY : 0; pg8::gemm_phase<prob::PDown, true>(lds, tab, P); }
        } else {
            const int i = l >> 1;
            SEAM(pb + 4);
            if (PHON(8) && IN(pb + 4)) { LOAD_IN(I); WSP(ws); router_phase(I, ws, l, lds); }
            SEAM(pb + 5);
            prob::MoeTab mt; mt.p = (LAS int*)(lds + MISC_OFF + 128);
            if (IN(pb + 5) || IN(pb + 6)) {
                __syncthreads();
                { const int t8 = launder_v(threadIdx.x); const unsigned* cnt = (const unsigned*)(ws0 + WS_CTL) + CW_CNT + i * 8 * 64;
                  if (t8 < 8) mt.p[32 + t8] = (int)__hip_atomic_load(cnt + t8 * 64, __ATOMIC_RELAXED, __HIP_MEMORY_SCOPE_AGENT);
                  __syncthreads();
                  if (t8 == 0) { int tp = 0, rb = 0;
                    for (int e = 0; e < 8; ++e) { const int c = mt.p[32 + e]; mt.p[e] = tp; mt.p[16 + e] = rb; tp += (c + 255) >> 8; rb += c; }
                    mt.p[8] = tp; } }
                __syncthreads();
            }
            REPS(9) if (PHON(9) && IN(pb + 5)) { WSP(ws); prob::PEGU P; P.A = (const char*)(ws + WS_AFFN); P.lda = 512; P.K = 512; P.Bt = (const char*)(ws + WS_EGU) + (size_t)i * NE * (2 * DFE) * 1024; P.ord.init(mt.ntiles(), 28, G, launder_s(bx));
                P.mt = mt; P.ws = ws; P.i = i;
                P.dry = rep_ > 0 ? REP_DRY : 0; pg8::gemm_phase<prob::PEGU, true>(lds, tab, P); }
            SEAM(pb + 6);
            REPS(10) if (PHON(10) && IN(pb + 6)) { WSP(ws); prob::PED P; P.A = (const char*)(ws + WS_ACT); P.lda = DFE / 2; P.K = DFE / 2; P.Bt = (const char*)(ws + WS_ED) + (size_t)i * NE * 1024 * DFE; P.ord.init(mt.ntiles(), 4, G, launder_s(bx));
                P.mt = mt; P.ws = ws;
                P.dry = rep_ > 0 ? REP_DRY : 0; pg8::gemm_phase<prob::PED, true>(lds, tab, P); }
            SEAM(pb + 7);
            if (PHON(11) && IN(pb + 7)) { LOAD_IN(I); WSP(ws); combine_phase(I, ws, args.out, l); }
        }
    }
#undef IN
#undef SEAM
}

#ifndef MK_ONE_LAUNCH
#define MK_ONE_LAUNCH 1
#endif
extern "C" void kernel_launch(void* const* d_in, const int* in_sizes, int n_in, void* d_out, int out_size, void* d_ws, size_t ws_size, hipStream_t stream) {
    static int grid = 0;
    if (grid == 0) {
        if (n_in != 24 || out_size != MT * DM || ws_size < WS_END) { fprintf(stderr, "kernel_launch: unexpected problem (n_in %d, out %d, ws %zu < %zu)\n", n_in, out_size, ws_size, (size_t)WS_END); grid = -1; return; }
        int dev = 0, cus = 0, per_cu = 0;
        if (hipGetDevice(&dev) != hipSuccess || hipDeviceGetAttribute(&cus, hipDeviceAttributeMultiprocessorCount, dev) != hipSuccess) { grid = -1; return; }
        if (hipFuncSetAttribute((const void*)fwd_kernel, hipFuncAttributeMaxDynamicSharedMemorySize, LDS_BYTES) != hipSuccess) { fprintf(stderr, "kernel_launch: hipFuncSetAttribute failed\n"); grid = -1; return; }
        if (hipOccupancyMaxActiveBlocksPerMultiprocessor(&per_cu, (const void*)fwd_kernel, 512, LDS_BYTES) != hipSuccess || per_cu < 1) { fprintf(stderr, "kernel_launch: occupancy query says %d\n", per_cu); grid = -1; (void)hipGetLastError(); return; }
        grid = cus;
    }
    if (grid < 0) return;
    (void)hipMemsetAsync((char*)d_ws + WS_CTL, 0, CTL_BYTES, stream);
    Args a{};
    for (int i = 0; i < 24; ++i) a.in[i] = d_in[i];
    a.out = (float*)d_out; a.ws = (unsigned char*)d_ws;
#if MK_ONE_LAUNCH
    a.lo = 0; a.hi = N_PHASE;
    hipLaunchKernelGGL(fwd_kernel, dim3(grid), dim3(512), LDS_BYTES, stream, a);
#else
    for (int p = 0; p < N_PHASE; ++p) {
        const int l = (p - 2) >> 3, j = (p - 2) & 7;
        if (p >= 2 && (l & 1) == 0 && j >= 6) continue;
        a.lo = p; a.hi = p + 1;
        hipLaunchKernelGGL(fwd_kernel, dim3(grid), dim3(512), LDS_BYTES, stream, a);
    }
#endif
}
```
